# Optimizing an MI355X kernel written in HIP

```python
import math
import jax
import jax.numpy as jnp
from jax import lax
import numpy as np

D_MODEL = 2048
BATCH = 4
SEQ = 4096
DEPTH = 2

GRID_W = 64
CTX_LEN = 256
HEAD_DIM = 128
ROPE_BASE = 10000.0
EPS = 1e-6
Q_BLOCK = 128

DIFF_HEADS = 8
DIFF_SUB = HEAD_DIM // 2
SWA_HEADS = 8
SWA_KV_HEADS = 2
SWA_GROUP = SWA_HEADS // SWA_KV_HEADS
WINDOW = 128

DIFF_Q = DIFF_HEADS * 2 * DIFF_SUB
DIFF_V = DIFF_HEADS * HEAD_DIM
SWA_Q = SWA_HEADS * HEAD_DIM
SWA_KV = SWA_KV_HEADS * HEAD_DIM
ATTN_IN = 2 * DIFF_Q + DIFF_V + SWA_Q + 2 * SWA_KV
ATTN_MIX = DIFF_V + SWA_Q

HYENA_ORDER = 2
HYENA_WIDTH = D_MODEL
SHORT_CONV = 3
FILTER_EMB = 33
FILTER_BANDS = (FILTER_EMB - 1) // 2
FILTER_HIDDEN = 64
DECAY_FAST = 0.3
DECAY_SLOW = 1.5
DECAY_TARGET = 1e-2

MOE_GROUPS = 4
MOE_PER_GROUP = 8
MOE_EXPERTS = MOE_GROUPS * MOE_PER_GROUP
MOE_TOPK = 2
MOE_FF = 1024
MOE_BLOCK = 256

kernel_name = 'hybrid_diffattn_swa_hyena_hmoe'


def _rms_norm(x, g):
    xf = x.astype(jnp.float32)
    y = xf * lax.rsqrt(jnp.mean(xf * xf, axis=-1, keepdims=True) + EPS)
    return (y * g.astype(jnp.float32)).astype(x.dtype)


def _heads(t, n, d):
    b, l, _ = t.shape
    return t.reshape(b, l, n, d).transpose(0, 2, 1, 3)


def _merge(t):
    b, n, l, d = t.shape
    return t.transpose(0, 2, 1, 3).reshape(b, l, n * d)


def _axial_rope(n_tokens, dim):
    n_rows = n_tokens // GRID_W
    row = jnp.repeat(jnp.arange(n_rows, dtype=jnp.float32), GRID_W)
    col = jnp.tile(jnp.arange(GRID_W, dtype=jnp.float32), n_rows)
    n_freq = dim // 4
    inv = ROPE_BASE ** (-jnp.arange(n_freq, dtype=jnp.float32) / n_freq)
    ang = jnp.concatenate([row[:, None] * inv, col[:, None] * inv], axis=-1)
    return jnp.cos(ang), jnp.sin(ang)


def _apply_rope(x, cos, sin):
    b, h, l, d = x.shape
    xp = x.reshape(b, h, l, d // 2, 2).astype(jnp.float32)
    x0, x1 = xp[..., 0], xp[..., 1]
    out = jnp.stack([x0 * cos - x1 * sin, x0 * sin + x1 * cos], axis=-1)
    return out.reshape(b, h, l, d).astype(x.dtype)


def _diff_attend(q, k, v, lam):
    s = jnp.einsum('bhqd,bhkd->bhqk', q, k).astype(jnp.float32)
    p = jax.nn.softmax(s, axis=-1)
    b, h2, nq, nk = p.shape
    p = p.reshape(b, h2 // 2, 2, nq, nk)
    a = p[:, :, 0] - lam * p[:, :, 1]
    return jnp.einsum('bhqk,bhkd->bhqd', a.astype(v.dtype), v)


def _sink_softmax(s, sink):
    m = jnp.maximum(jnp.max(s, axis=-1, keepdims=True), sink)
    e = jnp.exp(s - m)
    return e / (jnp.sum(e, axis=-1, keepdims=True) + jnp.exp(sink - m))


def _window_attend(q, k, v, kc, vc, sink):
    b, _, n, d = q.shape
    nb = n // Q_BLOCK
    span = Q_BLOCK + 2 * WINDOW
    qb = q.reshape(b, SWA_KV_HEADS, SWA_GROUP, nb, Q_BLOCK, d)
    idx = jnp.arange(nb)[:, None] * Q_BLOCK + jnp.arange(span)[None, :]
    pad = ((0, 0), (0, 0), (WINDOW, WINDOW), (0, 0))
    kb = jnp.pad(k, pad)[:, :, idx]
    vb = jnp.pad(v, pad)[:, :, idx]
    key_pos = idx - WINDOW
    rel = jnp.arange(span)[None, :] - jnp.arange(Q_BLOCK)[:, None]
    band = (rel >= 0) & (rel <= 2 * WINDOW)
    inside = (key_pos >= 0) & (key_pos < n)
    mask = band[None] & inside[:, None, :]
    s_loc = jnp.einsum('bhgnqd,bhnkd->bhgnqk', qb, kb).astype(jnp.float32)
    s_loc = jnp.where(mask, s_loc, -jnp.inf)
    s_ctx = jnp.einsum('bhgnqd,bhkd->bhgnqk', qb, kc).astype(jnp.float32)
    n_ctx = kc.shape[2]
    sk = sink.astype(jnp.float32).reshape(1, SWA_KV_HEADS, SWA_GROUP, 1, 1, 1)
    p = _sink_softmax(jnp.concatenate([s_ctx, s_loc], axis=-1), sk).astype(v.dtype)
    o = (jnp.einsum('bhgnqk,bhkd->bhgnqd', p[..., :n_ctx], vc)
         + jnp.einsum('bhgnqk,bhnkd->bhgnqd', p[..., n_ctx:], vb))
    return o.reshape(b, SWA_HEADS, n, d)


def _attention_mixer(h, hc, layer, ctx_live, w_in, w_out, dq_g, dk_g, lq1, lk1, lq2, lk2, dsub_g, sq_g, sk_g, sink):
    f32 = jnp.float32
    b, n, _ = h.shape
    cuts = [DIFF_Q, 2 * DIFF_Q, 2 * DIFF_Q + DIFF_V, 2 * DIFF_Q + DIFF_V + SWA_Q, 2 * DIFF_Q + DIFF_V + SWA_Q + SWA_KV]
    dq, dk, dv, sq, sk, sv = jnp.split(h @ w_in, cuts, axis=-1)
    cq, ck, cv, csq, csk, csv = jnp.split(hc @ w_in, cuts, axis=-1)
    lam_init = 0.8 - 0.6 * math.exp(-0.3 * layer)
    lam = (jnp.exp(jnp.sum((lq1 * lk1).astype(f32))) - jnp.exp(jnp.sum((lq2 * lk2).astype(f32))) + lam_init)
    sd = DIFF_SUB ** -0.5
    ss = HEAD_DIM ** -0.5
    cos_d, sin_d = _axial_rope(n, DIFF_SUB)
    cos_s, sin_s = _axial_rope(n, HEAD_DIM)

    q = _apply_rope(_rms_norm(_heads(dq, 2 * DIFF_HEADS, DIFF_SUB), dq_g), cos_d, sin_d) * sd
    k = _apply_rope(_rms_norm(_heads(dk, 2 * DIFF_HEADS, DIFF_SUB), dk_g), cos_d, sin_d)
    kc = _rms_norm(_heads(ck, 2 * DIFF_HEADS, DIFF_SUB), dk_g)
    vc = _heads(cv, DIFF_HEADS, HEAD_DIM)
    k_all = jnp.concatenate([kc, k], axis=2)
    v_all = jnp.concatenate([vc, _heads(dv, DIFF_HEADS, HEAD_DIM)], axis=2)
    nb = n // Q_BLOCK
    q_blocks = q.reshape(b, 2 * DIFF_HEADS, nb, Q_BLOCK, DIFF_SUB).transpose(2, 0, 1, 3, 4)
    o = lax.map(lambda qb: _diff_attend(qb, k_all, v_all, lam), q_blocks)
    o = o.transpose(1, 2, 0, 3, 4).reshape(b, DIFF_HEADS, n, HEAD_DIM)
    o_diff = _merge(_rms_norm(o, dsub_g) * (1.0 - lam_init))

    q2 = _apply_rope(_rms_norm(_heads(sq, SWA_HEADS, HEAD_DIM), sq_g), cos_s, sin_s) * ss
    k2 = _apply_rope(_rms_norm(_heads(sk, SWA_KV_HEADS, HEAD_DIM), sk_g), cos_s, sin_s)
    kc2 = _rms_norm(_heads(csk, SWA_KV_HEADS, HEAD_DIM), sk_g)
    vc2 = _heads(csv, SWA_KV_HEADS, HEAD_DIM)
    o_swa = _merge(_window_attend(q2, k2, _heads(sv, SWA_KV_HEADS, HEAD_DIM), kc2, vc2, sink))
    y = jnp.concatenate([o_diff, o_swa], axis=-1) @ w_out
    if not ctx_live:
        return y, None

    qc = _rms_norm(_heads(cq, 2 * DIFF_HEADS, DIFF_SUB), dq_g) * sd
    oc_diff = _merge(_rms_norm(_diff_attend(qc, kc, vc, lam), dsub_g) * (1.0 - lam_init))
    nc = hc.shape[1]
    qc2 = (_rms_norm(_heads(csq, SWA_HEADS, HEAD_DIM), sq_g) * ss).reshape(b, SWA_KV_HEADS, SWA_GROUP, nc, HEAD_DIM)
    sc = jnp.einsum('bhgqd,bhkd->bhgqk', qc2, kc2).astype(f32)
    pc = _sink_softmax(sc, sink.astype(f32).reshape(1, SWA_KV_HEADS, SWA_GROUP, 1, 1))
    oc_swa = jnp.einsum('bhgqk,bhkd->bhgqd', pc.astype(vc2.dtype), vc2).reshape(b, SWA_HEADS, nc, HEAD_DIM)
    yc = jnp.concatenate([oc_diff, _merge(oc_swa)], axis=-1) @ w_out
    return y, yc


def _short_conv(u, w, b):
    half = SHORT_CONV // 2
    n = u.shape[1]
    up = jnp.pad(u, ((0, 0), (half, half), (0, 0)))
    out = b
    for j in range(SHORT_CONV):
        out = out + up[:, j:j + n] * w[j]
    return out


def _hyena_filters(n, w1, b1, f1, w2, b2, f2, w3):
    t = jnp.linspace(0.0, 1.0, n, dtype=jnp.float32)[:, None]
    w = 2.0 * math.pi * jnp.arange(n, dtype=jnp.float32) / n
    f = jnp.linspace(1e-4, FILTER_BANDS - 1, FILTER_BANDS, dtype=jnp.float32)
    z = jnp.concatenate([t, jnp.cos(w[:, None] * f), -jnp.sin(w[:, None] * f)], axis=-1).astype(w1.dtype)
    a = jnp.sin(f1 * (z @ w1 + b1))
    a = jnp.sin(f2 * (a @ w2 + b2))
    hf = (a @ w3).astype(jnp.float32)
    max_decay = math.log(DECAY_TARGET) / DECAY_FAST
    min_decay = math.log(DECAY_TARGET) / DECAY_SLOW
    deltas = jnp.tile(jnp.linspace(min_decay, max_decay, HYENA_WIDTH, dtype=jnp.float32), 2 * HYENA_ORDER)
    hf = hf * jnp.exp(-t * jnp.abs(deltas))
    return hf.reshape(n, HYENA_ORDER, 2, HYENA_WIDTH)


def _long_conv(u, h_fwd, h_bwd, bias):
    n = u.shape[1]
    kern = jnp.concatenate([h_fwd, jnp.zeros_like(h_fwd[:1]), h_bwd[1:][::-1]], axis=0)
    uf = jnp.fft.rfft(u.astype(jnp.float32), n=2 * n, axis=1)
    kf = jnp.fft.rfft(kern, n=2 * n, axis=0)
    y = jnp.fft.irfft(uf * kf[None], n=2 * n, axis=1)[:, :n]
    return (y + u.astype(jnp.float32) * bias.astype(jnp.float32)).astype(u.dtype)


def _hyena_mixer(u, w_in, b_in, conv_w, conv_b, fw1, fb1, ff1, fw2, fb2, ff2, fw3, fbias, w_out, b_out):
    n = u.shape[1]
    z = _short_conv(u @ w_in + b_in, conv_w, conv_b)
    v, x1, x2 = jnp.split(z, 3, axis=-1)
    filt = _hyena_filters(n, fw1, fb1, ff1, fw2, fb2, ff2, fw3)
    y = x1 * _long_conv(v, filt[:, 0, 0], filt[:, 0, 1], fbias[0])
    y = x2 * _long_conv(y, filt[:, 1, 0], filt[:, 1, 1], fbias[1])
    return y @ w_out + b_out


def _expert_dispatch(t, expert, gates, w_gate, w_up, w_down):
    n, d = t.shape
    n_assign = n * MOE_TOPK
    flat = expert.reshape(-1)
    order = jnp.argsort(flat)
    e_sorted = flat[order]
    counts = jnp.bincount(flat, length=MOE_EXPERTS)
    padded = (counts + MOE_BLOCK - 1) // MOE_BLOCK * MOE_BLOCK
    pad_end = jnp.cumsum(padded)
    pad_start = pad_end - padded
    start = jnp.cumsum(counts) - counts
    slot_sorted = pad_start[e_sorted] + jnp.arange(n_assign) - start[e_sorted]
    slot = jnp.zeros_like(slot_sorted).at[order].set(slot_sorted)
    n_blocks = -(-n_assign // MOE_BLOCK) + MOE_EXPERTS
    src = jnp.full((n_blocks * MOE_BLOCK,), n, jnp.int32).at[slot].set(jnp.arange(n_assign, dtype=jnp.int32) // MOE_TOPK)
    xb = jnp.concatenate([t, jnp.zeros((1, d), t.dtype)], axis=0)[src].reshape(n_blocks, MOE_BLOCK, d)
    block_e = jnp.minimum(jnp.searchsorted(pad_end, jnp.arange(n_blocks) * MOE_BLOCK, side='right'), MOE_EXPERTS - 1)

    def expert_block(args):
        xs, e = args
        return (jax.nn.silu(xs @ w_gate[e]) * (xs @ w_up[e])) @ w_down[e]

    yb = lax.map(expert_block, (xb, block_e)).reshape(-1, d)
    y = yb[slot].reshape(n, MOE_TOPK, d)
    return jnp.einsum('nkd,nk->nd', y, gates.astype(y.dtype))


def _hier_moe(h, wg1, bg1, wg2, bg2, w_gate, w_up, w_down):
    shape = h.shape
    t = h.reshape(-1, shape[-1])
    n = t.shape[0]
    p_grp = jax.nn.softmax((t @ wg1).astype(jnp.float32) + bg1.astype(jnp.float32), axis=-1)
    p_top, grp = lax.top_k(p_grp, 1)
    lg = ((t @ wg2).astype(jnp.float32) + bg2.astype(jnp.float32)).reshape(n, MOE_GROUPS, MOE_PER_GROUP)
    lg = lg[jnp.arange(n), grp[:, 0]]
    top_lg, local = lax.top_k(lg, MOE_TOPK)
    gates = p_top * jax.nn.softmax(top_lg, axis=-1)
    expert = grp * MOE_PER_GROUP + local
    return _expert_dispatch(t, expert, gates, w_gate, w_up, w_down).reshape(shape)


def setup_inputs(seed: int = 0) -> dict:
    key = jax.random.key(seed)
    keys = jax.random.split(key, 48)
    counter = [0]

    def nrm(shape, scale):
        k = keys[counter[0]]
        counter[0] += 1
        return jax.random.normal(k, shape, jnp.float32) * scale

    def gain(shape):
        return 1.0 + nrm(shape, 0.05)

    D = D_MODEL
    W = HYENA_WIDTH
    ne = (DEPTH + 1) // 2
    no = DEPTH // 2
    return {
        'x': nrm((BATCH, SEQ, D), 1.0),
        'c': nrm((BATCH, D), 1.0),
        'ctx': nrm((BATCH, CTX_LEN, D), 1.0),
        'c_ctx': nrm((D,), 1.0),
        'ada_w': nrm((DEPTH, D, 6 * D), 0.5 * D ** -0.5),
        'ada_b': nrm((DEPTH, 6 * D), 0.01),
        'norm1_g': gain((DEPTH, D)),
        'norm2_g': gain((DEPTH, D)),
        'attn_w_in': nrm((ne, D, ATTN_IN), D ** -0.5),
        'attn_w_out': nrm((ne, ATTN_MIX, D), ATTN_MIX ** -0.5),
        'diff_q_g': gain((ne, DIFF_SUB)),
        'diff_k_g': gain((ne, DIFF_SUB)),
        'diff_lq1': nrm((ne, DIFF_SUB), 0.1),
        'diff_lk1': nrm((ne, DIFF_SUB), 0.1),
        'diff_lq2': nrm((ne, DIFF_SUB), 0.1),
        'diff_lk2': nrm((ne, DIFF_SUB), 0.1),
        'diff_sub_g': gain((ne, HEAD_DIM)),
        'swa_q_g': gain((ne, HEAD_DIM)),
        'swa_k_g': gain((ne, HEAD_DIM)),
        'swa_sink': nrm((ne, SWA_HEADS), 0.5),
        'hy_w_in': nrm((no, D, 3 * W), D ** -0.5),
        'hy_b_in': nrm((no, 3 * W), 0.02),
        'hy_conv_w': nrm((no, SHORT_CONV, 3 * W), SHORT_CONV ** -0.5),
        'hy_conv_b': nrm((no, 3 * W), 0.02),
        'flt_w1': nrm((no, FILTER_EMB, FILTER_HIDDEN), FILTER_EMB ** -0.5),
        'flt_b1': nrm((no, FILTER_HIDDEN), 0.1),
        'flt_f1': gain((no, FILTER_HIDDEN)),
        'flt_w2': nrm((no, FILTER_HIDDEN, FILTER_HIDDEN), FILTER_HIDDEN ** -0.5),
        'flt_b2': nrm((no, FILTER_HIDDEN), 0.1),
        'flt_f2': gain((no, FILTER_HIDDEN)),
        'flt_w3': nrm((no, FILTER_HIDDEN, 2 * HYENA_ORDER * W), 0.05 * FILTER_HIDDEN ** -0.5),
        'hy_bias': nrm((no, HYENA_ORDER, W), 0.5),
        'hy_w_out': nrm((no, W, D), W ** -0.5),
        'hy_b_out': nrm((no, D), 0.02),
        'moe_wg1': nrm((DEPTH, D, MOE_GROUPS), D ** -0.5),
        'moe_bg1': nrm((DEPTH, MOE_GROUPS), 0.01),
        'moe_wg2': nrm((DEPTH, D, MOE_EXPERTS), D ** -0.5),
        'moe_bg2': nrm((DEPTH, MOE_EXPERTS), 0.01),
        'moe_w_gate': nrm((DEPTH, MOE_EXPERTS, D, MOE_FF), D ** -0.5),
        'moe_w_up': nrm((DEPTH, MOE_EXPERTS, D, MOE_FF), D ** -0.5),
        'moe_w_down': nrm((DEPTH, MOE_EXPERTS, MOE_FF, D), MOE_FF ** -0.5),
    }


def reference(x, c, ctx, c_ctx, ada_w, ada_b, norm1_g, norm2_g, attn_w_in, attn_w_out, diff_q_g, diff_k_g, diff_lq1, diff_lk1, diff_lq2, diff_lk2, diff_sub_g, swa_q_g, swa_k_g, swa_sink, hy_w_in, hy_b_in, hy_conv_w, hy_conv_b, flt_w1, flt_b1, flt_f1, flt_w2, flt_b2, flt_f2, flt_w3, hy_bias, hy_w_out, hy_b_out, moe_wg1, moe_bg1, moe_wg2, moe_bg2, moe_w_gate, moe_w_up, moe_w_down):
    s_lat = jax.nn.silu(c)
    s_ctx = jax.nn.silu(c_ctx)
    for layer in range(DEPTH):
        even = layer % 2 == 0
        i = layer // 2
        ctx_live = any(j % 2 == 0 for j in range(layer + 1, DEPTH))
        mod = (s_lat @ ada_w[layer] + ada_b[layer])[:, None, :]
        sh1, sc1, g1, sh2, sc2, g2 = jnp.split(mod, 6, axis=-1)
        h = _rms_norm(x, norm1_g[layer]) * (1 + sc1) + sh1
        if even or ctx_live:
            cmod = s_ctx @ ada_w[layer] + ada_b[layer]
            csh1, csc1, cg1, csh2, csc2, cg2 = jnp.split(cmod, 6)
            hc = _rms_norm(ctx, norm1_g[layer]) * (1 + csc1) + csh1
        if even:
            y, yc = _attention_mixer(h, hc, layer, ctx_live, attn_w_in[i], attn_w_out[i], diff_q_g[i], diff_k_g[i],
                                     diff_lq1[i], diff_lk1[i], diff_lq2[i], diff_lk2[i], diff_sub_g[i],
                                     swa_q_g[i], swa_k_g[i], swa_sink[i])
        else:
            hy = (hy_w_in[i], hy_b_in[i], hy_conv_w[i], hy_conv_b[i], flt_w1[i], flt_b1[i], flt_f1[i],
                  flt_w2[i], flt_b2[i], flt_f2[i], flt_w3[i], hy_bias[i], hy_w_out[i], hy_b_out[i])
            y = _hyena_mixer(h, *hy)
            yc = _hyena_mixer(hc, *hy) if ctx_live else None
        moe = (moe_wg1[layer], moe_bg1[layer], moe_wg2[layer], moe_bg2[layer],
               moe_w_gate[layer], moe_w_up[layer], moe_w_down[layer])
        x = x + g1 * y
        x = x + g2 * _hier_moe(_rms_norm(x, norm2_g[layer]) * (1 + sc2) + sh2, *moe)
        if ctx_live:
            ctx = ctx + cg1 * yc
            ctx = ctx + cg2 * _hier_moe(_rms_norm(ctx, norm2_g[layer]) * (1 + csc2) + csh2, *moe)
    return x
```

```cpp
#include <hip/hip_runtime.h>
#include <stdint.h>
#include <string.h>

#ifndef N_LAUNCH_SPLIT
#define N_LAUNCH_SPLIT 1
#endif

typedef unsigned short u16;
typedef __attribute__((ext_vector_type(8))) short bf16x8;
typedef __attribute__((ext_vector_type(4))) float f32x4;
typedef __attribute__((ext_vector_type(16))) float f32x16;
typedef __attribute__((ext_vector_type(4))) unsigned u32x4;
typedef __attribute__((ext_vector_type(2))) unsigned u32x2;
#define DEV __device__ __forceinline__
#define LAS __attribute__((address_space(3)))

constexpr int DM = 2048, NB = 4, SEQ = 4096, NTOK = NB * SEQ, CTXL = 256;
constexpr int RB = CTXL + SEQ;
constexpr int NROW = NB * RB;
constexpr int AIN = 4608;
constexpr int NEXP = 32, FF = 1024, CAP = 32768;
constexpr float EPSN = 1e-6f;
constexpr float LOG2E = 1.4426950408889634f;
constexpr int NTHR = 256;
constexpr int LDS_BYTES = 73728;
constexpr int NPHASE = 20;

#define XB_TMO      128
#define XB_XCNT(j)  (256  + 64 * (j))
#define XB_XSUB(j)  (1280 + 64 * (j))
#define XB_XGEN(j)  (2304 + 64 * (j))
#define XB_TOP      3328
#define XB_TOPGEN   3392
#define XCD_BAR_WORDS 3456
#define XB_SPIN_CAP (1u << 22)
DEV unsigned xb_ld(unsigned* p)              { return __hip_atomic_load(p, __ATOMIC_RELAXED, __HIP_MEMORY_SCOPE_AGENT); }
DEV unsigned xb_add(unsigned* p, unsigned v) { return __hip_atomic_fetch_add(p, v, __ATOMIC_RELAXED, __HIP_MEMORY_SCOPE_AGENT); }
DEV unsigned xb_xcc_id() { return (unsigned)__builtin_amdgcn_s_getreg((3 << 11) | 20) & 0xFu; }
#define XB_SPIN(cond, bar) do { unsigned _sp = 0; while (cond) { __builtin_amdgcn_s_sleep(1); \
    if ((++_sp & 255u) == 0u) { if (xb_ld(&(bar)[XB_TMO])) break; if (_sp > XB_SPIN_CAP) { atomicAdd(&(bar)[XB_TMO], 1u); break; } } } } while (0)
struct XcdBarrier { unsigned* bar; unsigned x; volatile LAS unsigned* st; };
DEV XcdBarrier xcd_barrier_post(unsigned* bar, volatile LAS unsigned* st) {
    XcdBarrier b; b.bar = bar; b.x = xb_xcc_id(); b.st = st;
    if (threadIdx.x == 0) (void)xb_add(&bar[XB_XCNT(b.x)], 1u);
    return b;
}
DEV void xcd_barrier_complete(unsigned* bar, unsigned x, unsigned& nloc, unsigned& nx) {
    const unsigned G = gridDim.x * gridDim.y * gridDim.z;
    unsigned sum, cnt, mine, sp = 0u;
    for (;;) {
        sum = 0u; cnt = 0u; mine = 0u;
#pragma unroll
        for (unsigned j = 0; j < 16; ++j) { const unsigned c = xb_ld(&bar[XB_XCNT(j)]); sum += c; cnt += (c > 0u) ? 1u : 0u; mine = (j == x) ? c : mine; }
        if (sum == G) break;
        __builtin_amdgcn_s_sleep(1);
        if ((++sp & 255u) == 0u) { if (xb_ld(&bar[XB_TMO])) break; if (sp > XB_SPIN_CAP) { atomicAdd(&bar[XB_TMO], 1u); break; } }
    }
    nloc = mine > 0u ? mine : 1u; nx = cnt > 0u ? cnt : 1u;
}
DEV void xcd_barrier(const XcdBarrier& b) {
    asm volatile("s_waitcnt vmcnt(0)" ::: "memory");
    __syncthreads();
    if (threadIdx.x == 0) {
        unsigned* bar = b.bar;
        __builtin_amdgcn_s_waitcnt(0);
        unsigned nloc = b.st[0], nx = b.st[1];
        if (nloc == 0u) { xcd_barrier_complete(bar, b.x, nloc, nx); b.st[0] = nloc; b.st[1] = nx; }
        const unsigned old = xb_add(&bar[XB_XSUB(b.x)], 1u);
        const unsigned gen = old / nloc;
        if (old + 1u == (gen + 1u) * nloc) {
            __builtin_amdgcn_fence(__ATOMIC_RELEASE, "agent");
            asm volatile("s_waitcnt vmcnt(0)" ::: "memory");
            const unsigned og = xb_add(&bar[XB_TOP], 1u);
            const unsigned tg = og / nx;
            if (og + 1u == (tg + 1u) * nx) xb_add(&bar[XB_TOPGEN], 1u);
            else XB_SPIN(xb_ld(&bar[XB_TOPGEN]) == tg, bar);
            __builtin_amdgcn_fence(__ATOMIC_ACQUIRE, "agent");
            xb_add(&bar[XB_XGEN(b.x)], 1u);
            asm volatile("s_waitcnt vmcnt(0)" ::: "memory");
        } else {
            XB_SPIN(xb_ld(&bar[XB_XGEN(b.x)]) == gen, bar);
            __builtin_amdgcn_fence(__ATOMIC_ACQUIRE, "agent");
            asm volatile("s_waitcnt vmcnt(0)" ::: "memory");
        }
    }
    __syncthreads();
}

struct Params {
    const float *x, *c, *ctx, *c_ctx, *ada_w, *ada_b, *norm1_g, *norm2_g, *attn_w_in, *attn_w_out;
    const float *diff_q_g, *diff_k_g, *lq1, *lk1, *lq2, *lk2, *diff_sub_g, *swa_q_g, *swa_k_g, *swa_sink;
    const float *hy_w_in, *hy_b_in, *hy_conv_w, *hy_conv_b, *flt_w1, *flt_b1, *flt_f1, *flt_w2, *flt_b2, *flt_f2, *flt_w3;
    const float *hy_bias, *hy_w_out, *hy_b_out, *wg1, *bg1, *wg2, *bg2, *w_gate, *w_up, *w_down;
    float* out;
    unsigned* bar;
    float* mod;
    float2* tw;
    u16* a2;
    float* wr;
    unsigned* cnt;
    unsigned* list;
    float* gatev;
    u16* h;
    float* regA;
    u16* regB;
    float* regC;
    u16* attn_out;
    float* x1;
    float* x2;
    u16* h2hi; u16* h2lo;
    u16* act;
    float* filtT;
    float2* ksp;
    int ph_lo, ph_hi;
};

DEV unsigned cvt_pk_bf16(float lo, float hi) { unsigned r; asm volatile("v_cvt_pk_bf16_f32 %0, %1, %2" : "=v"(r) : "v"(lo), "v"(hi)); return r; }
DEV float bf2f(u16 v) { return __builtin_bit_cast(float, (unsigned)v << 16); }
DEV u16 f2bf(float f) { return (u16)(cvt_pk_bf16(f, 0.f) & 0xffffu); }
DEV float wave_sum(float v) {
#pragma unroll
    for (int m = 32; m >= 1; m >>= 1) v += __shfl_xor(v, m, 64);
    return v;
}
DEV float wave_max(float v) {
#pragma unroll
    for (int m = 32; m >= 1; m >>= 1) v = fmaxf(v, __shfl_xor(v, m, 64));
    return v;
}
DEV float silu(float v) { return v / (1.f + __expf(-v)); }
DEV f32x16 mfma32(bf16x8 a, bf16x8 b, f32x16 c) { return __builtin_amdgcn_mfma_f32_32x32x16_bf16(a, b, c, 0, 0, 0); }

DEV int chunk_off(int rows, int row, int g) { return ((g * rows + (row ^ ((g & 3) << 1))) << 4); }
constexpr int G_STAGE = 24576, G_BOFF = 16384;

template <int ROWS> struct LdRowBf16 {
    static constexpr int NCH = ROWS / 64;
    const u16* rp[NCH];
    u32x4 v[NCH];
    template <class F> DEV void init(F rowptr) {
        const int t = threadIdx.x;
#pragma unroll
        for (int i = 0; i < NCH; ++i) rp[i] = rowptr((t >> 2) + 64 * i) + (t & 3) * 8;
    }
    DEV void load(int kt) {
#pragma unroll
        for (int i = 0; i < NCH; ++i) v[i] = *(const u32x4*)(rp[i] + kt * 32);
    }
    DEV void store(char* base) {
        const int t = threadIdx.x;
#pragma unroll
        for (int i = 0; i < NCH; ++i) *(u32x4*)(base + chunk_off(ROWS, (t >> 2) + 64 * i, t & 3)) = v[i];
    }
};
template <int ROWS> struct LdRowBf16Split {
    static constexpr int NCH = ROWS / 64;
    const u16* rp[NCH];
    long dlo;
    u32x4 v[NCH];
    template <class F> DEV void init(F rowptr, long delta_lo) {
        const int t = threadIdx.x; dlo = delta_lo;
#pragma unroll
        for (int i = 0; i < NCH; ++i) rp[i] = rowptr((t >> 2) + 64 * i) + (t & 3) * 8;
    }
    DEV void load(int kt) {
        const long off = (long)(kt & 63) * 32 + ((kt >> 6) == 2 ? dlo : 0);
#pragma unroll
        for (int i = 0; i < NCH; ++i) v[i] = *(const u32x4*)(rp[i] + off);
    }
    DEV void store(char* base) {
        const int t = threadIdx.x;
#pragma unroll
        for (int i = 0; i < NCH; ++i) *(u32x4*)(base + chunk_off(ROWS, (t >> 2) + 64 * i, t & 3)) = v[i];
    }
};
template <int ROWS> struct LdKMajF32 {
    static constexpr int NU = ROWS / 128;
    const float* bp[NU];
    long ld;
    float2 v[NU][8];
    template <class F> DEV void init(F colptr, long ld_) {
        const int t = threadIdx.x; ld = ld_;
#pragma unroll
        for (int u = 0; u < NU; ++u) {
            const int id = t + 256 * u, p = id % (ROWS / 2), g = id / (ROWS / 2);
            bp[u] = colptr(2 * p) + (long)(g * 8) * ld;
        }
    }
    DEV void load(int kt) {
#pragma unroll
        for (int u = 0; u < NU; ++u)
#pragma unroll
            for (int j = 0; j < 8; ++j) v[u][j] = *(const float2*)(bp[u] + (long)(kt * 32 + j) * ld);
    }
    DEV void store(char* base) {
        const int t = threadIdx.x;
#pragma unroll
        for (int u = 0; u < NU; ++u) {
            const int id = t + 256 * u, p = id % (ROWS / 2), g = id / (ROWS / 2);
            u32x4 c0, c1;
            c0.x = cvt_pk_bf16(v[u][0].x, v[u][1].x); c0.y = cvt_pk_bf16(v[u][2].x, v[u][3].x);
            c0.z = cvt_pk_bf16(v[u][4].x, v[u][5].x); c0.w = cvt_pk_bf16(v[u][6].x, v[u][7].x);
            c1.x = cvt_pk_bf16(v[u][0].y, v[u][1].y); c1.y = cvt_pk_bf16(v[u][2].y, v[u][3].y);
            c1.z = cvt_pk_bf16(v[u][4].y, v[u][5].y); c1.w = cvt_pk_bf16(v[u][6].y, v[u][7].y);
            *(u32x4*)(base + chunk_off(ROWS, 2 * p, g)) = c0;
            *(u32x4*)(base + chunk_off(ROWS, 2 * p + 1, g)) = c1;
        }
    }
};

template <class AL, class BL>
DEV void gemm_mainloop(char* lds, AL& al, BL& bl, int nk, f32x16 (&acc)[4][2]) {
    const int t = threadIdx.x, lane = t & 63, w = t >> 6, wr = w >> 1, wc = w & 1;
    const int r = lane & 31, h = lane >> 5;
#pragma unroll
    for (int i = 0; i < 4; ++i)
#pragma unroll
        for (int j = 0; j < 2; ++j)
#pragma unroll
            for (int e = 0; e < 16; ++e) acc[i][j][e] = 0.f;
    __syncthreads();
    al.load(0); bl.load(0);
    al.store(lds); bl.store(lds + G_BOFF);
    if (nk > 1) { al.load(1); bl.load(1); }
    __syncthreads();
    for (int kt = 0; kt < nk; ++kt) {
        char* cur = lds + (kt & 1) * G_STAGE;
        char* nxt = lds + ((kt + 1) & 1) * G_STAGE;
        if (kt + 1 < nk) { al.store(nxt); bl.store(nxt + G_BOFF); }
        if (kt + 2 < nk) { al.load(kt + 2); bl.load(kt + 2); }
#pragma unroll
        for (int ks = 0; ks < 2; ++ks) {
            const int g = ks * 2 + h;
            bf16x8 af[4], bfr[2];
#pragma unroll
            for (int mt = 0; mt < 4; ++mt) af[mt] = *(const bf16x8*)(cur + chunk_off(256, wr * 128 + mt * 32 + r, g));
#pragma unroll
            for (int nt = 0; nt < 2; ++nt) bfr[nt] = *(const bf16x8*)(cur + G_BOFF + chunk_off(128, wc * 64 + nt * 32 + r, g));
#pragma unroll
            for (int mt = 0; mt < 4; ++mt)
#pragma unroll
                for (int nt = 0; nt < 2; ++nt) acc[mt][nt] = mfma32(af[mt], bfr[nt], acc[mt][nt]);
        }
        __syncthreads();
    }
}
#define ACC_ROW(wr, mt, e, h) ((wr) * 128 + (mt) * 32 + ((e) & 3) + 8 * ((e) >> 2) + 4 * (h))

DEV bool tile_map(int j, int T, int MT, int NT, int& mt, int& nt) {
    const int T8 = (T + 7) & ~7, per = T8 >> 3;
    const int w = (j & 7) * per + (j >> 3);
    if (w >= T) return false;
    const int nig = 8 * NT, gid = w / nig, fm = gid * 8;
    const int gsz = (MT - fm) < 8 ? (MT - fm) : 8;
    mt = fm + (w % nig) % gsz; nt = (w % nig) / gsz;
    return true;
}

DEV void row_load(const float* p, float4 (&v)[8], int lane) {
#pragma unroll
    for (int i = 0; i < 8; ++i) v[i] = *(const float4*)(p + 4 * lane + 256 * i);
}
DEV float row_rstd(const float4 (&v)[8]) {
    float ss = 0.f;
#pragma unroll
    for (int i = 0; i < 8; ++i) ss += v[i].x * v[i].x + v[i].y * v[i].y + v[i].z * v[i].z + v[i].w * v[i].w;
    ss = wave_sum(ss);
    return rsqrtf(ss * (1.f / DM) + EPSN);
}
DEV void row_modulate(float4 (&v)[8], float rstd, const float* g, const float* sc, const float* sh, int lane) {
#pragma unroll
    for (int i = 0; i < 8; ++i) {
        const int c = 4 * lane + 256 * i;
        const float4 gg = *(const float4*)(g + c), s = *(const float4*)(sc + c), b = *(const float4*)(sh + c);
        v[i].x = v[i].x * rstd * gg.x * (1.f + s.x) + b.x;
        v[i].y = v[i].y * rstd * gg.y * (1.f + s.y) + b.y;
        v[i].z = v[i].z * rstd * gg.z * (1.f + s.z) + b.z;
        v[i].w = v[i].w * rstd * gg.w * (1.f + s.w) + b.w;
    }
}
DEV void row_store_bf16(u16* p, const float4 (&v)[8], int lane) {
#pragma unroll
    for (int i = 0; i < 8; ++i) {
        u32x2 o; o.x = cvt_pk_bf16(v[i].x, v[i].y); o.y = cvt_pk_bf16(v[i].z, v[i].w);
        *(u32x2*)(p + 4 * lane + 256 * i) = o;
    }
}

DEV void phase_prologue(const Params& p, char* lds) {
    const int t = threadIdx.x, lane = t & 63, w = t >> 6;
    const int G = gridDim.x, bid = blockIdx.x;
    if (bid == 0 && t < 64) p.cnt[t] = 0u;
    if (bid < 384) {
        float* s = (float*)lds;
        float* part = (float*)(lds + 40960);
        for (int i = t; i < 5 * DM; i += NTHR) {
            const int r = i / DM, k = i % DM;
            s[i] = silu(r < 4 ? p.c[r * DM + k] : p.c_ctx[k]);
        }
        __syncthreads();
        for (int u = bid; u < 384; u += G) {
            const int layer = u / 192, col = (u % 192) * 64 + lane;
            const float* W = p.ada_w + (size_t)layer * DM * 12288 + col;
            float acc[5] = {0.f, 0.f, 0.f, 0.f, 0.f};
            const int k0 = w * 512;
            for (int k = k0; k < k0 + 512; k += 16) {
                float wv[16];
#pragma unroll
                for (int j = 0; j < 16; ++j) wv[j] = W[(size_t)(k + j) * 12288];
#pragma unroll
                for (int j = 0; j < 16; ++j)
#pragma unroll
                    for (int r = 0; r < 5; ++r) acc[r] += s[r * DM + k + j] * wv[j];
            }
#pragma unroll
            for (int r = 0; r < 5; ++r) part[(w * 5 + r) * 64 + lane] = acc[r];
            __syncthreads();
            if (w == 0) {
                const float bias = p.ada_b[layer * 12288 + col];
#pragma unroll
                for (int r = 0; r < 5; ++r)
                    p.mod[((size_t)layer * 5 + r) * 12288 + col] = part[(0 * 5 + r) * 64 + lane] + part[(1 * 5 + r) * 64 + lane] + part[(2 * 5 + r) * 64 + lane] + part[(3 * 5 + r) * 64 + lane] + bias;
            }
            __syncthreads();
        }
    }
    for (int j = bid * NTHR + t; j < 8192; j += G * NTHR) {
        float sn, cs; sincospif((float)j * (2.f / 8192.f), &sn, &cs);
        p.tw[j] = make_float2(cs, -sn);
    }
    {
        float* a1s = (float*)(lds + 48128);
        const int u = lane, sub = w;
        for (int n0 = bid * 4; n0 < SEQ; n0 += G * 4) {
            const int n = n0 + sub;
            const float tt = (float)n / (float)(SEQ - 1);
            const float wv = 6.283185307179586f * (float)n / (float)SEQ;
            float acc = p.flt_b1[u] + tt * p.flt_w1[0 * 64 + u];
#pragma unroll
            for (int j = 0; j < 16; ++j) {
                const float f = 1e-4f + (float)j * ((15.f - 1e-4f) / 15.f);
                const float a = wv * f;
                acc += cosf(a) * p.flt_w1[(1 + j) * 64 + u] - sinf(a) * p.flt_w1[(17 + j) * 64 + u];
            }
            const float a1 = sinf(p.flt_f1[u] * acc);
            __syncthreads();
            a1s[sub * 64 + u] = a1;
            __syncthreads();
            float acc2 = p.flt_b2[u];
#pragma unroll 8
            for (int v = 0; v < 64; ++v) acc2 += a1s[sub * 64 + v] * p.flt_w2[v * 64 + u];
            p.a2[n * 64 + u] = f2bf(sinf(p.flt_f2[u] * acc2));
        }
    }
    for (int i = bid * NTHR + t; i < 2 * 6144 * 128; i += G * NTHR) {
        const int col = i & 127, kk = (i >> 7) % 6144, l = i / (6144 * 128);
        const int seg = kk >> 11, k = kk & 2047;
        float v = 0.f;
        if (col < 36) {
            const float wv = col < 4 ? p.wg1[((size_t)l * DM + k) * 4 + col] : p.wg2[((size_t)l * DM + k) * 32 + (col - 4)];
            const float hi = bf2f(f2bf(wv));
            v = (seg == 1) ? (wv - hi) : hi;
        }
        p.wr[i] = v;
    }
}

DEV void phase_norm1_l0(const Params& p) {
    const int lane = threadIdx.x & 63, w = threadIdx.x >> 6;
    for (int rr = blockIdx.x * 4 + w; rr < NROW; rr += gridDim.x * 4) {
        const int b = rr / RB, i = rr % RB;
        const float* src = i < CTXL ? p.ctx + ((size_t)b * CTXL + i) * DM : p.x + ((size_t)b * SEQ + (i - CTXL)) * DM;
        const float* md = p.mod + (size_t)(i < CTXL ? 4 : b) * 12288;
        float4 v[8]; row_load(src, v, lane);
        const float rstd = row_rstd(v);
        row_modulate(v, rstd, p.norm1_g, md + 2048, md, lane);
        row_store_bf16(p.h + (size_t)rr * DM, v, lane);
    }
}
DEV void phase_filter_gemm(const Params& p, char* lds) {
    const int t = threadIdx.x, lane = t & 63, w = t >> 6, wr = w >> 1, wc = w & 1, r = lane & 31, h = lane >> 5;
    const int MT = 32, NT = 32, T = MT * NT;
    for (int j = blockIdx.x; j < ((T + 7) & ~7); j += gridDim.x) {
        int mt, nt; if (!tile_map(j, T, MT, NT, mt, nt)) continue;
        LdKMajF32<256> al; LdRowBf16<128> bl;
        al.init([&](int row) { return p.flt_w3 + mt * 256 + row; }, 8192);
        bl.init([&](int row) { return p.a2 + (size_t)(nt * 128 + row) * 64; });
        f32x16 acc[4][2];
        gemm_mainloop(lds, al, bl, 2, acc);
        const float min_decay = logf(1e-2f) / 1.5f, max_decay = logf(1e-2f) / 0.3f;
#pragma unroll
        for (int m = 0; m < 4; ++m)
#pragma unroll
            for (int e = 0; e < 16; ++e) {
                const int col = mt * 256 + ACC_ROW(wr, m, e, h);
                const int cc = col & 2047;
                const float delta = fabsf(min_decay + (max_decay - min_decay) * (float)cc / 2047.f);
#pragma unroll
                for (int n = 0; n < 2; ++n) {
                    const int nn = nt * 128 + wc * 64 + n * 32 + r;
                    const float tt = (float)nn / (float)(SEQ - 1);
                    p.filtT[(size_t)col * SEQ + nn] = acc[m][n][e] * __expf(-tt * delta);
                }
            }
    }
}

DEV void phase_attn_inproj(const Params& p, char* lds) {
    const int t = threadIdx.x, lane = t & 63, w = t >> 6, wr = w >> 1, wc = w & 1, r = lane & 31, h = lane >> 5;
    const int MT = NROW / 256, NT = AIN / 128, T = MT * NT;
    float* raw = p.regA;
    for (int j = blockIdx.x; j < ((T + 7) & ~7); j += gridDim.x) {
        int mt, nt; if (!tile_map(j, T, MT, NT, mt, nt)) continue;
        if ((mt % 17) == 0 && (nt < 8 || (nt >= 24 && nt < 32))) continue;
        LdRowBf16<256> al; LdKMajF32<128> bl;
        al.init([&](int row) { return p.h + (size_t)(mt * 256 + row) * DM; });
        bl.init([&](int row) { return p.attn_w_in + nt * 128 + row; }, AIN);
        f32x16 acc[4][2];
        gemm_mainloop(lds, al, bl, DM / 32, acc);
#pragma unroll
        for (int m = 0; m < 4; ++m)
#pragma unroll
            for (int e = 0; e < 16; ++e) {
                float* o = raw + (size_t)(mt * 256 + ACC_ROW(wr, m, e, h)) * AIN + nt * 128 + wc * 64 + r;
                o[0] = acc[m][0][e]; o[32] = acc[m][1][e];
            }
    }
}

DEV void phase_qknorm(const Params& p) {
    const int lane = threadIdx.x & 63, w = threadIdx.x >> 6;
    const float* raw = p.regA; u16* qkv = p.regB;
    for (int rr = blockIdx.x; rr < NROW; rr += gridDim.x) {
        const int i = rr % RB;
        const bool isctx = i < CTXL;
        const int pos = i - CTXL, prow = pos >> 6, pcol = pos & 63;
        for (int st = w; st < 36; st += 4) {
            const int c0 = st * 128;
            const int kind = c0 < 1024 ? 0 : c0 < 2048 ? 1 : c0 < 3072 ? 2 : c0 < 4096 ? 3 : c0 < 4352 ? 4 : 5;
            if (isctx && (kind == 0 || kind == 3)) continue;
            const float2 v = *(const float2*)(raw + (size_t)rr * AIN + c0 + 2 * lane);
            float o0 = v.x, o1 = v.y;
            if (kind == 0 || kind == 1) {
                float ss = v.x * v.x + v.y * v.y;
#pragma unroll
                for (int m = 16; m >= 1; m >>= 1) ss += __shfl_xor(ss, m, 64);
                const float rs = rsqrtf(ss * (1.f / 64.f) + EPSN);
                const float* g = (kind == 0 ? p.diff_q_g : p.diff_k_g) + 2 * (lane & 31);
                o0 = v.x * rs * g[0]; o1 = v.y * rs * g[1];
                if (!isctx) {
                    const int pi = lane & 31;
                    const float inv = exp2f(-13.287712379549449f * (float)(pi & 15) * (1.f / 16.f));
                    const float ang = (float)(pi < 16 ? prow : pcol) * inv;
                    float sn, cs; __sincosf(ang, &sn, &cs);
                    const float a = o0 * cs - o1 * sn, b = o0 * sn + o1 * cs;
                    o0 = a; o1 = b;
                }
                if (kind == 0) { o0 *= 0.125f * LOG2E; o1 *= 0.125f * LOG2E; }
            } else if (kind == 3 || kind == 4) {
                float ss = wave_sum(v.x * v.x + v.y * v.y);
                const float rs = rsqrtf(ss * (1.f / 128.f) + EPSN);
                const float* g = (kind == 3 ? p.swa_q_g : p.swa_k_g) + 2 * lane;
                o0 = v.x * rs * g[0]; o1 = v.y * rs * g[1];
                if (!isctx) {
                    const int pi = lane;
                    const float inv = exp2f(-13.287712379549449f * (float)(pi & 31) * (1.f / 32.f));
                    const float ang = (float)(pi < 32 ? prow : pcol) * inv;
                    float sn, cs; __sincosf(ang, &sn, &cs);
                    const float a = o0 * cs - o1 * sn, b = o0 * sn + o1 * cs;
                    o0 = a; o1 = b;
                }
                if (kind == 3) { o0 *= 0.08838834764831845f * LOG2E; o1 *= 0.08838834764831845f * LOG2E; }
            }
            *(unsigned*)(qkv + (size_t)rr * AIN + c0 + 2 * lane) = cvt_pk_bf16(o0, o1);
        }
    }
}

constexpr int AT_STAGE = 32768, AT_VOFF = 16384;
template <int DQK> struct KvLoader {
    static constexpr int NCK = DQK / 32;
    u32x4 kv[NCK], vv[4];
    unsigned koff[NCK], voff[4];
    DEV void init() {
        const int t = threadIdx.x;
#pragma unroll
        for (int i = 0; i < NCK; ++i) {
            const int c = t + 256 * i, g = c & (DQK / 8 - 1), key = c / (DQK / 8);
            koff[i] = (unsigned)(key * AIN + g * 8);
        }
        const int u = t & 1, dgl = (t >> 1) & 7, hi = t >> 4, cidx = hi & 7, dgh = hi >> 3, dg = dgh * 8 + dgl;
        const int kb = 16 * (cidx >> 1) + 8 * u + 4 * (cidx & 1);
#pragma unroll
        for (int i = 0; i < 4; ++i) voff[i] = (unsigned)((kb + i) * AIN + dg * 8);
    }
    DEV void load(const u16* kt_base, const u16* vt_base) {
#pragma unroll
        for (int i = 0; i < NCK; ++i) kv[i] = *(const u32x4*)(kt_base + koff[i]);
#pragma unroll
        for (int i = 0; i < 4; ++i) vv[i] = *(const u32x4*)(vt_base + voff[i]);
    }
    DEV void store(char* base) {
        const int t = threadIdx.x;
#pragma unroll
        for (int i = 0; i < NCK; ++i) {
            const int c = t + 256 * i, g = c & (DQK / 8 - 1), key = c / (DQK / 8);
            *(u32x4*)(base + ((g * 64 + (key ^ (g & 7))) << 4)) = kv[i];
        }
        const int u = t & 1, dgl = (t >> 1) & 7, hi = t >> 4, cidx = hi & 7, dgh = hi >> 3, dg = dgh * 8 + dgl;
#pragma unroll
        for (int dd = 0; dd < 8; ++dd) {
            const int wd = dd >> 1;
            u32x2 o;
            if ((dd & 1) == 0) { o.x = (vv[0][wd] & 0xffffu) | (vv[1][wd] << 16); o.y = (vv[2][wd] & 0xffffu) | (vv[3][wd] << 16); }
            else               { o.x = (vv[0][wd] >> 16) | (vv[1][wd] & 0xffff0000u); o.y = (vv[2][wd] >> 16) | (vv[3][wd] & 0xffff0000u); }
            const int d = dg * 8 + dd;
            *(u32x2*)(base + AT_VOFF + ((cidx * 128 + (d ^ (dg & 7))) << 4) + u * 8) = o;
        }
    }
};

template <int DQK, bool SWA>
DEV void attn_item(const Params& p, char* lds, int item, float M2, float sink_term_l2) {
    const int t = threadIdx.x, lane = t & 63, w = t >> 6, r = lane & 31, h = lane >> 5;
    const u16* qkv = p.regB;
    int b, qb, qcol, kcol, vcol, hs;
    if (!SWA) { qb = item & 31; hs = (item >> 5) & 15; b = item >> 9; qcol = hs * 64; kcol = 1024 + hs * 64; vcol = 2048 + (hs >> 1) * 128; }
    else      { qb = item & 31; hs = (item >> 5) & 7;  b = item >> 8; qcol = 3072 + hs * 128; kcol = 4096 + (hs >> 2) * 128; vcol = 4352 + (hs >> 2) * 128; }
    const size_t brow = (size_t)b * RB;
    int ntile, lo = 0;
    if (!SWA) ntile = RB / 64;
    else { lo = qb * 128 - 128; if (lo < 0) lo = 0; int hi_ = qb * 128 + 256; if (hi_ > SEQ) hi_ = SEQ; ntile = 4 + (hi_ - lo) / 64; }
    auto tile_row0 = [&](int kt) -> size_t { if (!SWA) return brow + (size_t)kt * 64; return kt < 4 ? brow + (size_t)kt * 64 : brow + CTXL + lo + (size_t)(kt - 4) * 64; };
    const int qpos = qb * 128 + w * 32 + r;
    const u16* qp = qkv + (brow + CTXL + qpos) * AIN + qcol + 8 * h;
    bf16x8 qf[DQK / 16];
#pragma unroll
    for (int ks = 0; ks < DQK / 16; ++ks) qf[ks] = *(const bf16x8*)(qp + 16 * ks);
    KvLoader<DQK> ld; ld.init();
    int kb4[4], vb2[2];
#pragma unroll
    for (int j = 0; j < 4; ++j) kb4[j] = ((r ^ (2 * j + h)) << 4) + 1024 * h;
#pragma unroll
    for (int j = 0; j < 2; ++j) vb2[j] = ((r ^ (4 * j + (r >> 3))) << 4) + 2048 * h;
    f32x16 O[4];
#pragma unroll
    for (int i = 0; i < 4; ++i)
#pragma unroll
        for (int e = 0; e < 16; ++e) O[i][e] = 0.f;
    float lsum = 0.f;
    __syncthreads();
    { const size_t r0 = tile_row0(0); ld.load(qkv + r0 * AIN + kcol, qkv + r0 * AIN + vcol); } ld.store(lds);
    if (ntile > 1) { const size_t r0 = tile_row0(1); ld.load(qkv + r0 * AIN + kcol, qkv + r0 * AIN + vcol); }
    __syncthreads();
    for (int kt = 0; kt < ntile; ++kt) {
        char* cur = lds + (kt & 1) * AT_STAGE;
        if (kt + 1 < ntile) ld.store(lds + ((kt + 1) & 1) * AT_STAGE);
        if (kt + 2 < ntile) { const size_t r0 = tile_row0(kt + 2); ld.load(qkv + r0 * AIN + kcol, qkv + r0 * AIN + vcol); }
        const bool local = SWA && kt >= 4;
        const int kpos0 = local ? lo + (kt - 4) * 64 : 0;
#pragma unroll
        for (int mk = 0; mk < 2; ++mk) {
            f32x16 S;
#pragma unroll
            for (int e = 0; e < 16; ++e) S[e] = -M2;
#pragma unroll
            for (int ks = 0; ks < DQK / 16; ++ks) {
                const bf16x8 kf = *(const bf16x8*)(cur + kb4[ks & 3] + (2048 * ks + 512 * mk));
                S = mfma32(kf, qf[ks], S);
            }
#pragma unroll
            for (int e = 0; e < 16; ++e) {
                float pv = __builtin_amdgcn_exp2f(S[e]);
                if (SWA) {
                    if (local) {
                        const int kp = kpos0 + mk * 32 + (e & 3) + 8 * (e >> 2) + 4 * h;
                        const int df = kp - qpos;
                        if (df > 128 || df < -128) pv = 0.f;
                    }
                }
                S[e] = pv; lsum += pv;
            }
#pragma unroll
            for (int s2 = 0; s2 < 2; ++s2) {
                const int a = s2 * 8;
                u32x4 pk;
                pk.x = cvt_pk_bf16(S[a + 0], S[a + 1]); pk.y = cvt_pk_bf16(S[a + 2], S[a + 3]);
                pk.z = cvt_pk_bf16(S[a + 4], S[a + 5]); pk.w = cvt_pk_bf16(S[a + 6], S[a + 7]);
                const bf16x8 pf = __builtin_bit_cast(bf16x8, pk);
#pragma unroll
                for (int md = 0; md < 4; ++md) {
                    const bf16x8 vf = *(const bf16x8*)(cur + AT_VOFF + vb2[md & 1] + (512 * md + 4096 * (mk * 2 + s2)));
                    O[md] = mfma32(vf, pf, O[md]);
                }
            }
            __builtin_amdgcn_sched_barrier(0);
        }
        __syncthreads();
    }
    float l = lsum + __shfl_xor(lsum, 32, 64);
    if (SWA) l += sink_term_l2;
    const float inv = 1.f / l;
    const size_t tok = (size_t)b * SEQ + qpos;
#pragma unroll
    for (int md = 0; md < 4; ++md)
#pragma unroll
        for (int rq = 0; rq < 4; ++rq) {
            const int d0 = md * 32 + 8 * rq + 4 * h;
            const float o0 = O[md][rq * 4 + 0] * inv, o1 = O[md][rq * 4 + 1] * inv, o2 = O[md][rq * 4 + 2] * inv, o3 = O[md][rq * 4 + 3] * inv;
            if (!SWA) *(float4*)(p.regC + tok * DM + hs * 128 + d0) = make_float4(o0, o1, o2, o3);
            else { u32x2 o; o.x = cvt_pk_bf16(o0, o1); o.y = cvt_pk_bf16(o2, o3); *(u32x2*)(p.attn_out + tok * DM + 1024 + hs * 128 + d0) = o; }
        }
}
DEV void phase_attention(const Params& p, char* lds) {
    const int lane = threadIdx.x & 63;
    const float mq = wave_max(fabsf(p.diff_q_g[lane])), mk = wave_max(fabsf(p.diff_k_g[lane]));
    const float M2d = LOG2E * mq * 8.f * mk * 1.02f;
    const float msq = wave_max(fmaxf(fabsf(p.swa_q_g[lane]), fabsf(p.swa_q_g[lane + 64])));
    const float msk = wave_max(fmaxf(fabsf(p.swa_k_g[lane]), fabsf(p.swa_k_g[lane + 64])));
    const float M2s = LOG2E * msq * 11.313708498984761f * msk * 1.02f;
#ifndef ATT_ONLY
#define ATT_ONLY 3
#endif
    if (ATT_ONLY & 1) for (int it = blockIdx.x; it < 2048; it += gridDim.x) attn_item<64, false>(p, lds, it, M2d, 0.f);
    if (ATT_ONLY & 2) for (int it = blockIdx.x; it < 1024; it += gridDim.x) {
        const int j = (it >> 5) & 7;
        attn_item<128, true>(p, lds, it, M2s, __builtin_amdgcn_exp2f(p.swa_sink[j] * LOG2E - M2s));
    }
}

DEV void phase_diff_combine(const Params& p) {
    const int lane = threadIdx.x & 63, w = threadIdx.x >> 6;
    const float s1 = wave_sum(p.lq1[lane] * p.lk1[lane]), s2 = wave_sum(p.lq2[lane] * p.lk2[lane]);
    const float lam_init = 0.2f;
    const float lam = expf(s1) - expf(s2) + lam_init;
    const float2 g = *(const float2*)(p.diff_sub_g + 2 * lane);
    for (int tok = blockIdx.x * 4 + w; tok < NTOK; tok += gridDim.x * 4) {
        const float* o = p.regC + (size_t)tok * DM;
#pragma unroll
        for (int hh = 0; hh < 8; ++hh) {
            const float2 a = *(const float2*)(o + (2 * hh) * 128 + 2 * lane), b = *(const float2*)(o + (2 * hh + 1) * 128 + 2 * lane);
            const float d0 = a.x - lam * b.x, d1 = a.y - lam * b.y;
            const float ss = wave_sum(d0 * d0 + d1 * d1);
            const float rs = rsqrtf(ss * (1.f / 128.f) + EPSN) * (1.f - lam_init);
            *(unsigned*)(p.attn_out + (size_t)tok * DM + hh * 128 + 2 * lane) = cvt_pk_bf16(d0 * rs * g.x, d1 * rs * g.y);
        }
    }
}

template <bool AKMAJ>
DEV void phase_outproj(const Params& p, char* lds, const u16* Abf, const float* Akm, const float* W, const float* bias, const float* xi, float* xo, const float* gmod  ) {
    const int t = threadIdx.x, lane = t & 63, w = t >> 6, wr = w >> 1, wc = w & 1, r = lane & 31, h = lane >> 5;
    const int MT = NTOK / 256, NT = DM / 128, T = MT * NT;
    for (int j = blockIdx.x; j < ((T + 7) & ~7); j += gridDim.x) {
        int mt, nt; if (!tile_map(j, T, MT, NT, mt, nt)) continue;
        f32x16 acc[4][2];
        LdKMajF32<128> bl;
        bl.init([&](int row) { return W + nt * 128 + row; }, DM);
        if (!AKMAJ) {
            LdRowBf16<256> al;
            al.init([&](int row) { return Abf + (size_t)(mt * 256 + row) * DM; });
            gemm_mainloop(lds, al, bl, DM / 32, acc);
        } else {
            LdKMajF32<256> al;
            al.init([&](int row) { return Akm + mt * 256 + row; }, NTOK);
            gemm_mainloop(lds, al, bl, DM / 32, acc);
        }
        const int bb = (mt * 256) / SEQ;
        const int col0 = nt * 128 + wc * 64 + r;
        const float gm0 = gmod[(size_t)bb * 12288 + col0], gm1 = gmod[(size_t)bb * 12288 + col0 + 32];
        const float bs0 = bias ? bias[col0] : 0.f, bs1 = bias ? bias[col0 + 32] : 0.f;
#pragma unroll
        for (int m = 0; m < 4; ++m)
#pragma unroll
            for (int e = 0; e < 16; ++e) {
                const size_t idx = (size_t)(mt * 256 + ACC_ROW(wr, m, e, h)) * DM + col0;
                xo[idx] = xi[idx] + gm0 * (acc[m][0][e] + bs0);
                xo[idx + 32] = xi[idx + 32] + gm1 * (acc[m][1][e] + bs1);
            }
    }
}

DEV void phase_norm2(const Params& p, int layer, const float* xin) {
    const int lane = threadIdx.x & 63, w = threadIdx.x >> 6;
    for (int rr = blockIdx.x * 4 + w; rr < NTOK; rr += gridDim.x * 4) {
        const int b = rr / SEQ;
        const float* md = p.mod + ((size_t)layer * 5 + b) * 12288;
        float4 v[8]; row_load(xin + (size_t)rr * DM, v, lane);
        const float rstd = row_rstd(v);
        row_modulate(v, rstd, p.norm2_g + layer * DM, md + 8192, md + 6144, lane);
#pragma unroll
        for (int i = 0; i < 8; ++i) {
            u32x2 hi; hi.x = cvt_pk_bf16(v[i].x, v[i].y); hi.y = cvt_pk_bf16(v[i].z, v[i].w);
            const float rx = v[i].x - __builtin_bit_cast(float, hi.x << 16), ry = v[i].y - __builtin_bit_cast(float, hi.x & 0xffff0000u);
            const float rz = v[i].z - __builtin_bit_cast(float, hi.y << 16), rw = v[i].w - __builtin_bit_cast(float, hi.y & 0xffff0000u);
            u32x2 lo; lo.x = cvt_pk_bf16(rx, ry); lo.y = cvt_pk_bf16(rz, rw);
            *(u32x2*)(p.h2hi + (size_t)rr * DM + 4 * lane + 256 * i) = hi;
            *(u32x2*)(p.h2lo + (size_t)rr * DM + 4 * lane + 256 * i) = lo;
        }
    }
}

DEV void phase_router(const Params& p, char* lds, int layer) {
    const int t = threadIdx.x, lane = t & 63, w = t >> 6, wr = w >> 1, wc = w & 1, r = lane & 31, h = lane >> 5;
    const int MT = NTOK / 256;
    float* lg = (float*)lds;
    unsigned* lcnt = (unsigned*)(lds + 40960);
    for (int mt = blockIdx.x; mt < MT; mt += gridDim.x) {
        LdRowBf16Split<256> al; LdKMajF32<128> bl;
        al.init([&](int row) { return p.h2hi + (size_t)(mt * 256 + row) * DM; }, (long)(p.h2lo - p.h2hi));
        bl.init([&](int row) { return p.wr + (size_t)layer * 6144 * 128 + row; }, 128);
        f32x16 acc[4][2];
        gemm_mainloop(lds, al, bl, 192, acc);
        if (wc == 0) {
#pragma unroll
            for (int n = 0; n < 2; ++n) {
                const int col = n * 32 + r;
                if (col < 36) {
#pragma unroll
                    for (int m = 0; m < 4; ++m)
#pragma unroll
                        for (int e = 0; e < 16; ++e) lg[ACC_ROW(wr, m, e, h) * 37 + col] = acc[m][n][e];
                }
            }
        }
        if (t < 32) lcnt[t] = 0u;
        __syncthreads();
        int e0, e1, rk0, rk1; float g0, g1;
        {
            const float* L = lg + t * 37;
            float gl[4];
#pragma unroll
            for (int i = 0; i < 4; ++i) gl[i] = L[i] + p.bg1[layer * 4 + i];
            int grp = 0; float gmx = gl[0];
#pragma unroll
            for (int i = 1; i < 4; ++i) if (gl[i] > gmx) { gmx = gl[i]; grp = i; }
            float den = 0.f;
#pragma unroll
            for (int i = 0; i < 4; ++i) den += expf(gl[i] - gmx);
            const float ptop = 1.f / den;
            float v1 = -3.4e38f, v2 = -3.4e38f; int i1 = 0, i2 = 0;
#pragma unroll
            for (int i = 0; i < 8; ++i) {
                const float v = L[4 + grp * 8 + i] + p.bg2[layer * 32 + grp * 8 + i];
                if (v > v1) { v2 = v1; i2 = i1; v1 = v; i1 = i; }
                else if (v > v2) { v2 = v; i2 = i; }
            }
            const float ex = expf(v2 - v1);
            g0 = ptop / (1.f + ex); g1 = ptop * ex / (1.f + ex);
            e0 = grp * 8 + i1; e1 = grp * 8 + i2;
            rk0 = (int)atomicAdd(&lcnt[e0], 1u); rk1 = (int)atomicAdd(&lcnt[e1], 1u);
        }
        __syncthreads();
        if (t < 32) lcnt[32 + t] = atomicAdd(&p.cnt[layer * 32 + t], lcnt[t]);
        __syncthreads();
        {
            const unsigned tok = mt * 256 + t;
            p.list[(size_t)e0 * CAP + lcnt[32 + e0] + rk0] = tok * 2u;
            p.list[(size_t)e1 * CAP + lcnt[32 + e1] + rk1] = tok * 2u + 1u;
            p.gatev[tok * 2] = g0; p.gatev[tok * 2 + 1] = g1;
        }
        __syncthreads();
    }
}

DEV int moe_tables(const Params& p, char* lds, int layer) {
    int* tab = (int*)(lds + 49152);
    __syncthreads();
    if (threadIdx.x == 0) {
        int mp = 0, ro = 0;
        for (int e = 0; e < NEXP; ++e) {
            const int c = (int)p.cnt[layer * 32 + e];
            tab[e] = mp; tab[40 + e] = ro; tab[80 + e] = c;
            const int m = (c + 255) >> 8; mp += m; ro += m * 256;
        }
        tab[32] = mp;
    }
    __syncthreads();
    return tab[32];
}
DEV void moe_find(const char* lds, int gm, int& e, int& mloc, int& rowoff, int& cnt) {
    const int* tab = (const int*)(lds + 49152);
    e = 0;
#pragma unroll 1
    for (int i = 1; i < NEXP; ++i) if (tab[i] <= gm) e = i;
    mloc = gm - tab[e]; rowoff = tab[40 + e]; cnt = tab[80 + e];
}
DEV void phase_moe1(const Params& p, char* lds, int layer) {
    const int t = threadIdx.x, lane = t & 63, w = t >> 6, wr = w >> 1, wc = w & 1, r = lane & 31, h = lane >> 5;
    const int MT = moe_tables(p, lds, layer), NT = FF / 64, T = MT * NT;
    for (int j = blockIdx.x; j < ((T + 7) & ~7); j += gridDim.x) {
        int gm, nt; if (!tile_map(j, T, MT, NT, gm, nt)) continue;
        int e, mloc, rowoff, cnt; moe_find(lds, gm, e, mloc, rowoff, cnt);
        const unsigned* lst = p.list + (size_t)e * CAP;
        LdRowBf16<256> al; LdKMajF32<128> bl;
        al.init([&](int row) { int idx = mloc * 256 + row; if (idx >= cnt) idx = cnt - 1; return p.h2hi + (size_t)(lst[idx] >> 1) * DM; });
        const size_t wbase = ((size_t)layer * NEXP + e) * DM * FF;
        bl.init([&](int row) { const int q = row >> 5; return ((q & 1) ? p.w_up : p.w_gate) + wbase + nt * 64 + (q >> 1) * 32 + (row & 31); }, FF);
        f32x16 acc[4][2];
        gemm_mainloop(lds, al, bl, DM / 32, acc);
        const int col = nt * 64 + wc * 32 + r;
#pragma unroll
        for (int m = 0; m < 4; ++m)
#pragma unroll
            for (int ee = 0; ee < 16; ++ee) {
                const int idx = mloc * 256 + ACC_ROW(wr, m, ee, h);
                if (idx < cnt) {
                    const float gt = acc[m][0][ee], up = acc[m][1][ee];
                    p.act[(size_t)(rowoff + idx) * FF + col] = f2bf(silu(gt) * up);
                }
            }
    }
}
DEV void phase_moe2(const Params& p, char* lds, int layer) {
    const int t = threadIdx.x, lane = t & 63, w = t >> 6, wr = w >> 1, wc = w & 1, r = lane & 31, h = lane >> 5;
    const int MT = moe_tables(p, lds, layer), NT = DM / 128, T = MT * NT;
    float* Y = p.regA;
    for (int j = blockIdx.x; j < ((T + 7) & ~7); j += gridDim.x) {
        int gm, nt; if (!tile_map(j, T, MT, NT, gm, nt)) continue;
        int e, mloc, rowoff, cnt; moe_find(lds, gm, e, mloc, rowoff, cnt);
        const unsigned* lst = p.list + (size_t)e * CAP;
        LdRowBf16<256> al; LdKMajF32<128> bl;
        al.init([&](int row) { int idx = mloc * 256 + row; if (idx >= cnt) idx = cnt - 1; return p.act + (size_t)(rowoff + idx) * FF; });
        bl.init([&](int row) { return p.w_down + ((size_t)layer * NEXP + e) * FF * DM + nt * 128 + row; }, DM);
        f32x16 acc[4][2];
        gemm_mainloop(lds, al, bl, FF / 32, acc);
#pragma unroll
        for (int m = 0; m < 4; ++m)
#pragma unroll
            for (int ee = 0; ee < 16; ++ee) {
                const int idx = mloc * 256 + ACC_ROW(wr, m, ee, h);
                if (idx < cnt) {
                    const size_t a = lst[idx];
#pragma unroll
                    for (int n = 0; n < 2; ++n) Y[a * DM + nt * 128 + wc * 64 + n * 32 + r] = acc[m][n][ee];
                }
            }
    }
}

template <bool FINAL>
DEV void phase_combine(const Params& p, int layer, const float* xin, float* xout) {
    const int lane = threadIdx.x & 63, w = threadIdx.x >> 6;
    const float* Y = p.regA;
    for (int rr = blockIdx.x * 4 + w; rr < NTOK; rr += gridDim.x * 4) {
        const int b = rr / SEQ;
        const float* md = p.mod + ((size_t)layer * 5 + b) * 12288;
        const float ga = p.gatev[rr * 2], gb = p.gatev[rr * 2 + 1];
        float4 v[8]; row_load(xin + (size_t)rr * DM, v, lane);
#pragma unroll
        for (int i = 0; i < 8; ++i) {
            const int c = 4 * lane + 256 * i;
            const float4 ya = *(const float4*)(Y + (size_t)(2 * rr) * DM + c), yb = *(const float4*)(Y + (size_t)(2 * rr + 1) * DM + c);
            const float4 g2 = *(const float4*)(md + 10240 + c);
            v[i].x += g2.x * (ga * ya.x + gb * yb.x); v[i].y += g2.y * (ga * ya.y + gb * yb.y);
            v[i].z += g2.z * (ga * ya.z + gb * yb.z); v[i].w += g2.w * (ga * ya.w + gb * yb.w);
            *(float4*)(xout + (size_t)rr * DM + c) = v[i];
        }
        if (!FINAL) {
            const float* md1 = p.mod + ((size_t)(layer + 1) * 5 + b) * 12288;
            const float rstd = row_rstd(v);
            row_modulate(v, rstd, p.norm1_g + (layer + 1) * DM, md1 + 2048, md1, lane);
            row_store_bf16(p.h + (size_t)rr * DM, v, lane);
        }
    }
}

DEV void phase_hy_inproj(const Params& p, char* lds) {
    const int t = threadIdx.x, lane = t & 63, w = t >> 6, wr = w >> 1, wc = w & 1, r = lane & 31, h = lane >> 5;
    const int MT = 6144 / 256, NT = NTOK / 128, T = MT * NT;
    u16* zT = p.regB;
    for (int j = blockIdx.x; j < ((T + 7) & ~7); j += gridDim.x) {
        int mt, nt; if (!tile_map(j, T, MT, NT, mt, nt)) continue;
        LdKMajF32<256> al; LdRowBf16<128> bl;
        al.init([&](int row) { return p.hy_w_in + mt * 256 + row; }, 6144);
        bl.init([&](int row) { return p.h + (size_t)(nt * 128 + row) * DM; });
        f32x16 acc[4][2];
        gemm_mainloop(lds, al, bl, DM / 32, acc);
#pragma unroll
        for (int m = 0; m < 4; ++m)
#pragma unroll
            for (int e = 0; e < 16; ++e) {
                const int col = mt * 256 + ACC_ROW(wr, m, e, h);
                const float bs = p.hy_b_in[col];
#pragma unroll
                for (int n = 0; n < 2; ++n) zT[(size_t)col * NTOK + nt * 128 + wc * 64 + n * 32 + r] = f2bf(acc[m][n][e] + bs);
            }
    }
}

template <class T> DEV T* uni(T* p) {
    const unsigned long long v = (unsigned long long)p;
    const unsigned lo = __builtin_amdgcn_readfirstlane((unsigned)v), hi = __builtin_amdgcn_readfirstlane((unsigned)(v >> 32));
    return (T*)(((unsigned long long)hi << 32) | lo);
}
DEV int tid_opaque() { int t = threadIdx.x; asm volatile("" : "+v"(t)); return t; }
DEV float2 cmul(float2 a, float2 b) { return make_float2(a.x * b.x - a.y * b.y, a.x * b.y + a.y * b.x); }
DEV float2 cmulc(float2 a, float2 b) { return make_float2(a.x * b.x + a.y * b.y, a.y * b.x - a.x * b.y); }
DEV int PIX(int i) { return i + (i >> 4); }
constexpr float cCos32[16] = {1.f, 0.98078528040323043f, 0.92387953251128674f, 0.83146961230254524f, 0.70710678118654752f, 0.55557023301960218f, 0.38268343236508977f, 0.19509032201612825f,
                              0.f, -0.19509032201612825f, -0.38268343236508977f, -0.55557023301960218f, -0.70710678118654752f, -0.83146961230254524f, -0.92387953251128674f, -0.98078528040323043f};
constexpr float cSin32[16] = {0.f, 0.19509032201612825f, 0.38268343236508977f, 0.55557023301960218f, 0.70710678118654752f, 0.83146961230254524f, 0.92387953251128674f, 0.98078528040323043f,
                              1.f, 0.98078528040323043f, 0.92387953251128674f, 0.83146961230254524f, 0.70710678118654752f, 0.55557023301960218f, 0.38268343236508977f, 0.19509032201612825f};
constexpr int brev(int v, int bits) { int o = 0; for (int i = 0; i < bits; ++i) if (v & (1 << i)) o |= 1 << (bits - 1 - i); return o; }
template <int R, bool INV> DEV void dft_regs(float2 (&a)[R]) {
    constexpr int LOGR = (R == 32) ? 5 : 4;
#pragma unroll
    for (int half = R / 2; half >= 1; half >>= 1) {
#pragma unroll
        for (int blk = 0; blk < R; blk += 2 * half) {
#pragma unroll
            for (int i = 0; i < half; ++i) {
                const float2 u = a[blk + i], v = a[blk + i + half];
                a[blk + i] = make_float2(u.x + v.x, u.y + v.y);
                const float2 d = make_float2(u.x - v.x, u.y - v.y);
                const int ti = i * (16 / half);
                if (ti == 0) a[blk + i + half] = d;
                else if (ti == 8) a[blk + i + half] = INV ? make_float2(-d.y, d.x) : make_float2(d.y, -d.x);
                else {
                    const float c = cCos32[ti], s = INV ? cSin32[ti] : -cSin32[ti];
                    a[blk + i + half] = make_float2(d.x * c - d.y * s, d.x * s + d.y * c);
                }
            }
        }
    }
    float2 b[R];
#pragma unroll
    for (int k = 0; k < R; ++k) b[k] = a[brev(k, LOGR)];
#pragma unroll
    for (int k = 0; k < R; ++k) a[k] = b[k];
}
template <int R, bool CONJ> DEV void apply_pows(float2 (&a)[R], float2 w1) {
    float2 B[4]; B[0] = make_float2(1.f, 0.f); B[1] = w1; B[2] = cmul(w1, w1); B[3] = cmul(B[2], w1);
    const float2 w4 = cmul(B[2], B[2]);
    float2 A = make_float2(1.f, 0.f);
#pragma unroll
    for (int q = 0; q < R / 4; ++q) {
#pragma unroll
        for (int b = 0; b < 4; ++b) {
            if (q == 0 && b == 0) continue;
            const float2 wk = (q == 0) ? B[b] : (b == 0 ? A : cmul(A, B[b]));
            a[q * 4 + b] = CONJ ? cmulc(a[q * 4 + b], wk) : cmul(a[q * 4 + b], wk);
        }
        A = cmul(A, w4);
    }
}
DEV void fft_s1_fwd(float2* X, const float2* tw, float2 (&a)[32]) {
    const int t = tid_opaque();
    dft_regs<32, false>(a);
    __builtin_amdgcn_sched_barrier(0);
    apply_pows<32, false>(a, tw[t]);
    float2* Xb = X + (t + (t >> 4));
#pragma unroll
    for (int k = 0; k < 32; ++k) Xb[272 * k] = a[k];
}
DEV void fft_s1_inv(const float2* X, const float2* tw, float2 (&a)[32]) {
    const int t = tid_opaque();
    const float2* Xb = X + (t + (t >> 4));
#pragma unroll
    for (int k = 0; k < 32; ++k) a[k] = Xb[272 * k];
    apply_pows<32, true>(a, tw[t]);
    __builtin_amdgcn_sched_barrier(0);
    dft_regs<32, true>(a);
}
template <bool INV> DEV void fft_s2(float2* X, const float2* tw) {
#pragma unroll 1
    for (int i = 0; i < 2; ++i) {
        const int id = tid_opaque() + 256 * i, k = id >> 4, j2 = id & 15;
        float2 a[16];
#pragma unroll
        for (int m = 0; m < 16; ++m) a[m] = X[PIX(256 * k + j2 + 16 * m)];
        if (!INV) { dft_regs<16, false>(a); apply_pows<16, false>(a, tw[32 * j2]); }
        else      { apply_pows<16, true>(a, tw[32 * j2]); dft_regs<16, true>(a); }
#pragma unroll
        for (int m = 0; m < 16; ++m) X[PIX(256 * k + j2 + 16 * m)] = a[m];
    }
}
DEV void fft_s3_store(const float2* X, float2* ksp, float scale) {
#pragma unroll 1
    for (int i = 0; i < 2; ++i) {
        const int tt = tid_opaque(), id = tt + 256 * i, base = 16 * id;
        float2 a[16];
#pragma unroll
        for (int m = 0; m < 16; ++m) a[m] = X[PIX(base + m)];
        dft_regs<16, false>(a);
#pragma unroll
        for (int m = 0; m < 16; ++m) ksp[(unsigned)((i * 16 + m) * 256 + tt)] = make_float2(a[m].x * scale, a[m].y * scale);
    }
}
DEV void fft_s3_mul(float2* X, const float2* ksp) {
#pragma unroll 1
    for (int i = 0; i < 2; ++i) {
        const int tt = tid_opaque(), id = tt + 256 * i, base = 16 * id;
        float2 a[16];
#pragma unroll
        for (int m = 0; m < 16; ++m) a[m] = X[PIX(base + m)];
        dft_regs<16, false>(a);
#pragma unroll
        for (int m = 0; m < 16; ++m) a[m] = cmul(a[m], ksp[(unsigned)((i * 16 + m) * 256 + tt)]);
        dft_regs<16, true>(a);
#pragma unroll
        for (int m = 0; m < 16; ++m) X[PIX(base + m)] = a[m];
    }
}
template <bool MUL> DEV void sconv_fill(float2 (&a)[32], const u16* row  , int b0, float w0, float w1, float w2, float cb) {
    const int t = tid_opaque();
    const unsigned i0 = (unsigned)(b0 * SEQ + t);
#pragma unroll
    for (int m = 0; m < 16; ++m) {
        const unsigned i = i0 + 256u * m;
        float l0, l1, r0, r1;
        if (m == 0)  { const unsigned o = t > 0 ? 1u : 0u; const float k = t > 0 ? 1.f : 0.f; l0 = k * bf2f(row[i - o]); l1 = k * bf2f(row[i + SEQ - o]); }
        else         { l0 = bf2f(row[i - 1]); l1 = bf2f(row[i + SEQ - 1]); }
        if (m == 15) { const unsigned o = t < 255 ? 1u : 0u; const float k = t < 255 ? 1.f : 0.f; r0 = k * bf2f(row[i + o]); r1 = k * bf2f(row[i + SEQ + o]); }
        else         { r0 = bf2f(row[i + 1]); r1 = bf2f(row[i + SEQ + 1]); }
        const float v0 = cb + w0 * l0 + w1 * bf2f(row[i]) + w2 * r0;
        const float v1 = cb + w0 * l1 + w1 * bf2f(row[i + SEQ]) + w2 * r1;
        if (MUL) { a[m].x *= v0; a[m].y *= v1; } else a[m] = make_float2(v0, v1);
        if ((m & 3) == 3) __builtin_amdgcn_sched_barrier(0);
    }
}
DEV void phase_hy_conv(const Params& p, char* lds) {
    float2* X = (float2*)lds;
    const u16* zT = p.regB; float* y2T = p.regC;
    float2* ksp = uni(p.ksp + (size_t)blockIdx.x * 2 * 8192);
    const float2* tw = uni(p.tw);
#pragma unroll 1
    for (int c = blockIdx.x; c < DM; c += gridDim.x) {
#pragma unroll 1
        for (int o = 0; o < 2; ++o) {
            const float* hf = uni(p.filtT + (size_t)(o * 4096 + c) * SEQ);
            const float* hb = uni(p.filtT + (size_t)(o * 4096 + 2048 + c) * SEQ);
            float2 a[32];
            const int t = tid_opaque();
#pragma unroll
            for (int m = 0; m < 16; ++m) a[m] = make_float2(hf[(unsigned)(t + 256 * m)], 0.f);
            if (t == 0) a[0].x += p.hy_bias[o * DM + c];
            a[16] = make_float2(t == 0 ? 0.f : hb[(unsigned)(SEQ - t) - (t == 0 ? 1u : 0u)], 0.f);
#pragma unroll
            for (int m = 17; m < 32; ++m) a[m] = make_float2(hb[(unsigned)(SEQ - t - 256 * (m - 16))], 0.f);
            __syncthreads();
            fft_s1_fwd(X, tw, a);
            __syncthreads();
            fft_s2<false>(X, tw);
            __syncthreads();
            fft_s3_store(X, ksp + o * 8192, 1.f / 8192.f);
        }
        const u16* rv = uni(zT + (size_t)c * NTOK);
        const u16* r1 = uni(zT + (size_t)(2048 + c) * NTOK);
        const u16* r2 = uni(zT + (size_t)(4096 + c) * NTOK);
#pragma unroll 1
        for (int pr = 0; pr < 2; ++pr) {
            const int b0 = 2 * pr;
            float2 a[32];
            sconv_fill<false>(a, rv, b0, p.hy_conv_w[c], p.hy_conv_w[6144 + c], p.hy_conv_w[12288 + c], p.hy_conv_b[c]);
#pragma unroll
            for (int m = 16; m < 32; ++m) a[m] = make_float2(0.f, 0.f);
            __syncthreads();
            fft_s1_fwd(X, tw, a);
            __syncthreads();
            fft_s2<false>(X, tw);
            __syncthreads();
            fft_s3_mul(X, ksp);
            __syncthreads();
            fft_s2<true>(X, tw);
            __syncthreads();
            fft_s1_inv(X, tw, a);
            sconv_fill<true>(a, r1, b0, p.hy_conv_w[2048 + c], p.hy_conv_w[6144 + 2048 + c], p.hy_conv_w[12288 + 2048 + c], p.hy_conv_b[2048 + c]);
#pragma unroll
            for (int m = 16; m < 32; ++m) a[m] = make_float2(0.f, 0.f);
            fft_s1_fwd(X, tw, a);
            __syncthreads();
            fft_s2<false>(X, tw);
            __syncthreads();
            fft_s3_mul(X, ksp + 8192);
            __syncthreads();
            fft_s2<true>(X, tw);
            __syncthreads();
            fft_s1_inv(X, tw, a);
            sconv_fill<true>(a, r2, b0, p.hy_conv_w[4096 + c], p.hy_conv_w[6144 + 4096 + c], p.hy_conv_w[12288 + 4096 + c], p.hy_conv_b[4096 + c]);
            float* yo = uni(y2T + (size_t)c * NTOK);
            const int t = tid_opaque();
#pragma unroll
            for (int m = 0; m < 16; ++m) { yo[(unsigned)(b0 * SEQ + t + 256 * m)] = a[m].x; yo[(unsigned)(b0 * SEQ + SEQ + t + 256 * m)] = a[m].y; }
        }
        __syncthreads();
    }
}

__global__ void __launch_bounds__(NTHR, 2) mega(Params p) {
    extern __shared__ __attribute__((aligned(16))) char lds[];
    uint4* xbw = (uint4*)(lds + LDS_BYTES - 16);
    const bool multi = (p.ph_hi - p.ph_lo) > 1;
    XcdBarrier bar;
    bar.bar = p.bar; bar.x = 0; bar.st = (volatile LAS unsigned*)xbw;
    if (multi) {
        if (threadIdx.x == 0) *xbw = make_uint4(0u, 0u, 0u, 0u);
        __syncthreads();
        bar = xcd_barrier_post(p.bar, (volatile LAS unsigned*)xbw);
    }
#ifndef ONLY_PHASE
#define ONLY_PHASE -1
#endif
#define PH(n, body) if ((ONLY_PHASE < 0 || ONLY_PHASE == (n)) && p.ph_lo <= (n) && (n) < p.ph_hi) { body; if ((n) + 1 < p.ph_hi) xcd_barrier(bar); }
    const float* mod0g1 = p.mod + 4096;
    const float* mod1g1 = p.mod + (size_t)5 * 12288 + 4096;
    PH(0,  phase_prologue(p, lds))
    PH(1,  { phase_norm1_l0(p); phase_filter_gemm(p, lds); })
    PH(2,  phase_attn_inproj(p, lds))
    PH(3,  phase_qknorm(p))
    PH(4,  phase_attention(p, lds))
    PH(5,  phase_diff_combine(p))
    PH(6,  (phase_outproj<false>(p, lds, p.attn_out, nullptr, p.attn_w_out, nullptr, p.x, p.x1, mod0g1)))
    PH(7,  phase_norm2(p, 0, p.x1))
    PH(8,  phase_router(p, lds, 0))
    PH(9,  phase_moe1(p, lds, 0))
    PH(10, phase_moe2(p, lds, 0))
    PH(11, (phase_combine<false>(p, 0, p.x1, p.x2)))
    PH(12, phase_hy_inproj(p, lds))
    PH(13, phase_hy_conv(p, lds))
    PH(14, (phase_outproj<true>(p, lds, nullptr, p.regC, p.hy_w_out, p.hy_b_out, p.x2, p.x1, mod1g1)))
    PH(15, phase_norm2(p, 1, p.x1))
    PH(16, phase_router(p, lds, 1))
    PH(17, phase_moe1(p, lds, 1))
    PH(18, phase_moe2(p, lds, 1))
    PH(19, (phase_combine<true>(p, 1, p.x1, p.out)))
}

extern "C" void kernel_launch(void* const* d_in, const int* in_sizes, int n_in, void* d_out, int out_size, void* d_ws, size_t ws_size, hipStream_t stream) {
    static int grid = 0;
    if (!grid) {
        int dev = 0, cus = 0, per_cu = 0;
        hipGetDevice(&dev);
        hipDeviceGetAttribute(&cus, hipDeviceAttributeMultiprocessorCount, dev);
        hipFuncSetAttribute((const void*)mega, hipFuncAttributeMaxDynamicSharedMemorySize, LDS_BYTES);
        hipOccupancyMaxActiveBlocksPerMultiprocessor(&per_cu, mega, NTHR, LDS_BYTES);
        if (per_cu > 2) per_cu = 2;
        if (per_cu < 1) per_cu = 1;
        grid = cus * per_cu;
    }
    Params p; memset(&p, 0, sizeof(p));
    const float* const* in = (const float* const*)d_in;
    p.x = in[0]; p.c = in[1]; p.ctx = in[2]; p.c_ctx = in[3]; p.ada_w = in[4]; p.ada_b = in[5]; p.norm1_g = in[6]; p.norm2_g = in[7];
    p.attn_w_in = in[8]; p.attn_w_out = in[9]; p.diff_q_g = in[10]; p.diff_k_g = in[11]; p.lq1 = in[12]; p.lk1 = in[13]; p.lq2 = in[14]; p.lk2 = in[15];
    p.diff_sub_g = in[16]; p.swa_q_g = in[17]; p.swa_k_g = in[18]; p.swa_sink = in[19];
    p.hy_w_in = in[20]; p.hy_b_in = in[21]; p.hy_conv_w = in[22]; p.hy_conv_b = in[23];
    p.flt_w1 = in[24]; p.flt_b1 = in[25]; p.flt_f1 = in[26]; p.flt_w2 = in[27]; p.flt_b2 = in[28]; p.flt_f2 = in[29]; p.flt_w3 = in[30];
    p.hy_bias = in[31]; p.hy_w_out = in[32]; p.hy_b_out = in[33];
    p.wg1 = in[34]; p.bg1 = in[35]; p.wg2 = in[36]; p.bg2 = in[37]; p.w_gate = in[38]; p.w_up = in[39]; p.w_down = in[40];
    p.out = (float*)d_out;
    char* ws = (char*)d_ws; size_t off = 0;
    auto take = [&](size_t bytes) { char* r = ws + off; off += (bytes + 255) & ~(size_t)255; return r; };
    p.bar = (unsigned*)take(XCD_BAR_WORDS * 4);
    p.mod = (float*)take((size_t)2 * 5 * 12288 * 4);
    p.tw = (float2*)take(8192 * 8);
    p.a2 = (u16*)take((size_t)4096 * 64 * 2);
    p.wr = (float*)take((size_t)2 * 6144 * 128 * 4);
    p.cnt = (unsigned*)take(64 * 4);
    p.list = (unsigned*)take((size_t)NEXP * CAP * 4);
    p.gatev = (float*)take((size_t)32768 * 4);
    p.h = (u16*)take((size_t)NROW * DM * 2);
    p.regA = (float*)take((size_t)NROW * AIN * 4);
    p.regB = (u16*)take((size_t)6144 * NTOK * 2);
    p.regC = (float*)take((size_t)NTOK * DM * 4);
    p.attn_out = (u16*)take((size_t)NTOK * DM * 2);
    p.x1 = (float*)take((size_t)NTOK * DM * 4);
    p.x2 = (float*)take((size_t)NTOK * DM * 4);
    p.h2hi = (u16*)take((size_t)NTOK * DM * 2);
    p.h2lo = (u16*)take((size_t)NTOK * DM * 2);
    p.act = (u16*)take((size_t)40960 * FF * 2);
    p.filtT = (float*)take((size_t)8192 * SEQ * 4);
    p.ksp = (float2*)take((size_t)grid * 2 * 8192 * 8);
#if N_LAUNCH_SPLIT
    for (int ph = 0; ph < NPHASE; ++ph) {
        p.ph_lo = ph; p.ph_hi = ph + 1;
        hipLaunchKernelGGL(mega, dim3(grid), dim3(NTHR), LDS_BYTES, stream, p);
    }
#else
    hipMemsetAsync(p.bar, 0, XCD_BAR_WORDS * 4, stream);
    p.ph_lo = 0; p.ph_hi = NPHASE;
    hipLaunchKernelGGL(mega, dim3(grid), dim3(NTHR), LDS_BYTES, stream, p);
#endif
}
```

```cpp
#include <hip/hip_runtime.h>
#include <stdint.h>
#include <string.h>

#ifndef N_LAUNCH_SPLIT
#define N_LAUNCH_SPLIT 0
#endif

typedef unsigned short u16;
typedef __attribute__((ext_vector_type(8))) short bf16x8;
typedef __attribute__((ext_vector_type(4))) float f32x4;
typedef __attribute__((ext_vector_type(16))) float f32x16;
typedef __attribute__((ext_vector_type(4))) unsigned u32x4;
typedef __attribute__((ext_vector_type(2))) unsigned u32x2;
#define DEV __device__ __forceinline__
#define LAS __attribute__((address_space(3)))

constexpr int DM = 2048, NB = 4, SEQ = 4096, NTOK = NB * SEQ, CTXL = 256;
constexpr int RB = CTXL + SEQ;
constexpr int NROW = NB * RB;
constexpr int AIN = 4608;
constexpr int NEXP = 32, FF = 1024, NSLOT = 40960;
constexpr float EPSN = 1e-6f;
constexpr float LOG2E = 1.4426950408889634f;
constexpr int NTHR = 512, NW = 8;
constexpr int LDS_BYTES = 147456;
constexpr int LDS_TAB = 139264;
constexpr int NPHASE = 21;
constexpr int NTILE = NROW / 64;
constexpr size_t IMG_KD = 0, IMG_VD = IMG_KD + (size_t)16 * NTILE * 8192, IMG_KS = IMG_VD + (size_t)8 * NTILE * 16384, IMG_VS = IMG_KS + (size_t)2 * NTILE * 16384;

#define XB_TMO      128
#define XB_XCNT(j)  (256  + 64 * (j))
#define XB_XSUB(j)  (1280 + 64 * (j))
#define XB_XGEN(j)  (2304 + 64 * (j))
#define XB_TOP      3328
#define XB_TOPGEN   3392
#define XCD_BAR_WORDS 3456
#define XB_SPIN_CAP (1u << 22)
DEV unsigned xb_ld(unsigned* p)              { return __hip_atomic_load(p, __ATOMIC_RELAXED, __HIP_MEMORY_SCOPE_AGENT); }
DEV unsigned xb_add(unsigned* p, unsigned v) { return __hip_atomic_fetch_add(p, v, __ATOMIC_RELAXED, __HIP_MEMORY_SCOPE_AGENT); }
DEV unsigned xb_xcc_id() { return (unsigned)__builtin_amdgcn_s_getreg((3 << 11) | 20) & 0xFu; }
#define XB_SPIN(cond, bar) do { unsigned _sp = 0; while (cond) { __builtin_amdgcn_s_sleep(1); \
    if ((++_sp & 255u) == 0u) { if (xb_ld(&(bar)[XB_TMO])) break; if (_sp > XB_SPIN_CAP) { atomicAdd(&(bar)[XB_TMO], 1u); break; } } } } while (0)
struct XcdBarrier { unsigned* bar; unsigned x; volatile LAS unsigned* st; };
DEV XcdBarrier xcd_barrier_post(unsigned* bar, volatile LAS unsigned* st) {
    XcdBarrier b; b.bar = bar; b.x = xb_xcc_id(); b.st = st;
    if (threadIdx.x == 0) (void)xb_add(&bar[XB_XCNT(b.x)], 1u);
    return b;
}
DEV void xcd_barrier_complete(unsigned* bar, unsigned x, unsigned& nloc, unsigned& nx) {
    const unsigned G = gridDim.x * gridDim.y * gridDim.z;
    unsigned sum, cnt, mine, sp = 0u;
    for (;;) {
        sum = 0u; cnt = 0u; mine = 0u;
#pragma unroll
        for (unsigned j = 0; j < 16; ++j) { const unsigned c = xb_ld(&bar[XB_XCNT(j)]); sum += c; cnt += (c > 0u) ? 1u : 0u; mine = (j == x) ? c : mine; }
        if (sum == G) break;
        __builtin_amdgcn_s_sleep(1);
        if ((++sp & 255u) == 0u) { if (xb_ld(&bar[XB_TMO])) break; if (sp > XB_SPIN_CAP) { atomicAdd(&bar[XB_TMO], 1u); break; } }
    }
    nloc = mine > 0u ? mine : 1u; nx = cnt > 0u ? cnt : 1u;
}
DEV void xcd_barrier(const XcdBarrier& b, int tid_) {
    asm volatile("s_waitcnt vmcnt(0)" ::: "memory");
    __syncthreads();
    if (tid_ == 0) {
        unsigned* bar = b.bar;
        __builtin_amdgcn_s_waitcnt(0);
        unsigned nloc = b.st[0], nx = b.st[1];
        if (nloc == 0u) { xcd_barrier_complete(bar, b.x, nloc, nx); b.st[0] = nloc; b.st[1] = nx; }
        const unsigned old = xb_add(&bar[XB_XSUB(b.x)], 1u);
        const unsigned gen = old / nloc;
        if (old + 1u == (gen + 1u) * nloc) {
            __builtin_amdgcn_fence(__ATOMIC_RELEASE, "agent");
            asm volatile("s_waitcnt vmcnt(0)" ::: "memory");
            const unsigned og = xb_add(&bar[XB_TOP], 1u);
            const unsigned tg = og / nx;
            if (og + 1u == (tg + 1u) * nx) xb_add(&bar[XB_TOPGEN], 1u);
            else XB_SPIN(xb_ld(&bar[XB_TOPGEN]) == tg, bar);
            __builtin_amdgcn_fence(__ATOMIC_ACQUIRE, "agent");
            xb_add(&bar[XB_XGEN(b.x)], 1u);
            asm volatile("s_waitcnt vmcnt(0)" ::: "memory");
        } else {
            XB_SPIN(xb_ld(&bar[XB_XGEN(b.x)]) == gen, bar);
            __builtin_amdgcn_fence(__ATOMIC_ACQUIRE, "agent");
            asm volatile("s_waitcnt vmcnt(0)" ::: "memory");
        }
    }
    __syncthreads();
}

struct Params {
    const float *x, *c, *ctx, *c_ctx, *ada_w, *ada_b, *norm1_g, *norm2_g, *attn_w_in, *attn_w_out;
    const float *diff_q_g, *diff_k_g, *lq1, *lk1, *lq2, *lk2, *diff_sub_g, *swa_q_g, *swa_k_g, *swa_sink;
    const float *hy_w_in, *hy_b_in, *hy_conv_w, *hy_conv_b, *flt_w1, *flt_b1, *flt_f1, *flt_w2, *flt_b2, *flt_f2, *flt_w3;
    const float *hy_bias, *hy_w_out, *hy_b_out, *wg1, *bg1, *wg2, *bg2, *w_gate, *w_up, *w_down;
    float* out;
    unsigned* bar;
    float* mod;
    float2* tw;
    u16* a2p;
    float* gains;
    unsigned* cnt;
    unsigned* route;
    unsigned* inv;
    float* gatev;
    u16 *wt_attn_in, *wt_attn_out, *wt_hy_in, *wt_hy_out, *wt_w3;
    u16 *wt_gu, *wt_dn;
    u16* h;
    float* regA;
    u16* regB;
    float* regC;
    u16* attn_out;
    float* x1;
    float* x2;
    u16* h2;
    u16* act;
    float* filtT;
    float2* ksp;
    int ph_lo, ph_hi;
};

typedef __bf16 bf16x2_t __attribute__((ext_vector_type(2)));
typedef float f32x2_t __attribute__((ext_vector_type(2)));
DEV unsigned cvt_pk_bf16n(float lo, float hi) { f32x2_t v = {lo, hi}; return __builtin_bit_cast(unsigned, __builtin_convertvector(v, bf16x2_t)); }
DEV unsigned cvt_pk_bf16(float lo, float hi) { unsigned r; asm volatile("v_cvt_pk_bf16_f32 %0, %1, %2" : "=v"(r) : "v"(lo), "v"(hi)); return r; }
DEV float bf2f(u16 v) { return __builtin_bit_cast(float, (unsigned)v << 16); }
DEV u16 f2bf(float f) { return (u16)(cvt_pk_bf16(f, 0.f) & 0xffffu); }
DEV float wave_sum(float v) {
#pragma unroll
    for (int m = 32; m >= 1; m >>= 1) v += __shfl_xor(v, m, 64);
    return v;
}
DEV float wave_max(float v) {
#pragma unroll
    for (int m = 32; m >= 1; m >>= 1) v = fmaxf(v, __shfl_xor(v, m, 64));
    return v;
}
DEV float silu(float v) { return v / (1.f + __expf(-v)); }
DEV f32x16 mfma32(bf16x8 a, bf16x8 b, f32x16 c) { return __builtin_amdgcn_mfma_f32_32x32x16_bf16(a, b, c, 0, 0, 0); }

namespace pg8 {
constexpr int BM = 256, BK = 64, HALF = 128, HTB = HALF * BK * 2, STAGE_BYTES = 8 * HTB, NXCD = 8, WGM = 8;
DEV int lds_byte(int r, int c) { const int st = (r >> 4) * 2 + (c >> 5), rr = r & 15, cc = c & 31, ob = rr * 64 + cc * 2; return st * 1024 + (ob ^ (((ob >> 9) & 1) << 5)); }
DEV void stage_rc(int b, int& R, int& C) { const int st = b / 1024, sb = b % 1024, swz = sb ^ (((sb >> 9) & 1) << 5); R = (st >> 1) * 16 + swz / 64; C = (st & 1) * 32 + (swz % 64) / 2; }
struct Unit { int row0, col0; const char* a; const char* b; const unsigned* gl; int gcnt; };
DEV int xcd_remap(int wgid, int nwg) { const int q = nwg / NXCD, r = nwg % NXCD, xcd = wgid % NXCD, off = wgid / NXCD; return (xcd < r ? xcd * (q + 1) : r * (q + 1) + (xcd - r) * q) + off; }
struct StaticOrder {
    const char* A; const char* Bt; size_t tstep; int nM, nN, nwg, G, c;
    DEV void init(const void* A_, const void* Bt_, int M, int N, int K) { A = (const char*)A_; Bt = (const char*)Bt_; tstep = (size_t)BM * K * 2; nM = M / BM; nN = N / BM; nwg = nM * nN; G = gridDim.x; c = blockIdx.x; }
    DEV bool next(int i, Unit& u) const {
        const long L = (long)i * G + c; if (L >= nwg) return false;
        const int wgid = xcd_remap((int)L, nwg);
        const int nig = WGM * nN, gid = wgid / nig, fm = gid * WGM, gsz = (nM - fm) < WGM ? (nM - fm) : WGM;
        const int pm = fm + ((wgid % nig) % gsz), pn = (wgid % nig) / gsz;
        u.row0 = pm * BM; u.col0 = pn * BM; u.a = A + (size_t)pm * tstep; u.b = Bt + (size_t)pn * tstep; u.gl = nullptr; u.gcnt = 0; return true;
    }
};
struct MoeOrder {
    const char* A; const char* W; size_t a_rowbytes, w_expert_bytes, w_tstep; const int* tab; int nwg, G, c; const unsigned* inv;
    DEV void init(const void* A_, int Ka, const void* W_, size_t wexp_elems, const int* tab_, const unsigned* inv_) {
        inv = inv_; A = (const char*)A_; a_rowbytes = (size_t)Ka * 2; W = (const char*)W_; w_expert_bytes = wexp_elems * 2; w_tstep = (size_t)BM * Ka * 2; tab = tab_; nwg = tab_[32]; G = gridDim.x; c = blockIdx.x; }
    DEV bool next(int i, Unit& u) const {
        const long L = (long)i * G + c; if (L >= nwg) return false;
        const int w = xcd_remap((int)L, nwg);
        int e = 0;
#pragma unroll 1
        for (int j = 1; j < NEXP; ++j) if (tab[j] <= w) e = j;
        const int rem = w - tab[e], mt = tab[40 + e], pn = rem / mt, pml = rem - pn * mt;
        u.row0 = tab[80 + e] + pml * BM; u.col0 = pn * BM;
        u.b = W + (size_t)e * w_expert_bytes + (size_t)pn * w_tstep;
        if (inv) { u.a = A; u.gl = inv + (size_t)e * 32768 + pml * BM; u.gcnt = tab[120 + e] - pml * BM; }
        else     { u.a = A + (size_t)u.row0 * a_rowbytes; u.gl = nullptr; u.gcnt = 0; }
        return true;
    }
};

template <bool GATHER, class Epi, class Sched>
DEV void gemm_phase(LAS unsigned char* lds, const int K, const Sched& S, const Epi& E, int tid_) {
    const int tid = tid_, wid = __builtin_amdgcn_readfirstlane(tid >> 6), lane = tid & 63, wr = wid >> 2, wc = wid & 3, fr = lane & 15, fq = lane >> 4;
    const int nt = K / BK;
    unsigned voff[2];
#pragma unroll
    for (int i = 0; i < 2; ++i) { int R, C; stage_rc(tid * 16 + i * 8192, R, C); voff[i] = (unsigned)(R * K + C) * 2u; }
    unsigned gA[2][2];
    auto load_gather = [&](const Unit& u, unsigned (&g)[2][2]) {
        int tz = tid; asm volatile("" : "+v"(tz));
#pragma unroll
        for (int hh = 0; hh < 2; ++hh)
#pragma unroll
            for (int i = 0; i < 2; ++i) { int R, C; stage_rc(tz * 16 + i * 8192, R, C); int idx = hh * HALF + R; if (idx >= u.gcnt) idx = u.gcnt - 1; g[hh][i] = u.gl[idx] * (unsigned)(K * 2) + (unsigned)C * 2u; }
    };
    const size_t kstep = (size_t)(BK * 2);
    const size_t hstep = (size_t)HALF * K * 2;
    const unsigned ldsw = (unsigned)wid * 1024u;
    const int aoff = lds_byte(wr * 64 + fr, fq * 8), boff = lds_byte(wc * 32 + fr, fq * 8);
#define PG8_SA(b, h) (((b) * 2 + (h)) * HTB)
#define PG8_SB(b, h) ((4 + (b) * 2 + (h)) * HTB)
#define PG8_STAGE(bufoff, gbase) do { _Pragma("unroll") for (int _i = 0; _i < 2; ++_i) \
        __builtin_amdgcn_global_load_lds((const unsigned*)((const char*)(gbase) + voff[_i]), (LAS unsigned*)(lds + (bufoff) + ldsw + _i * 8192), 16, 0, 0); } while (0)
#define PG8_STAGE_A(bufoff, gbase, hsel, gsel) do { if (GATHER) { _Pragma("unroll") for (int _i = 0; _i < 2; ++_i) \
        __builtin_amdgcn_global_load_lds((const unsigned*)((const char*)(gbase) + (gsel)[hsel][_i]), (LAS unsigned*)(lds + (bufoff) + ldsw + _i * 8192), 16, 0, 0); } \
        else PG8_STAGE(bufoff, (gbase) + (hsel) * hstep); } while (0)
#define PG8_LDA(dst, b, h) do { _Pragma("unroll") for (int m = 0; m < 4; ++m) _Pragma("unroll") for (int k = 0; k < 2; ++k) dst[m][k] = *(const LAS bf16x8*)(lds + PG8_SA(b, h) + aoff + m * 2048 + k * 1024); } while (0)
#define PG8_LDB(dst, b, h) do { _Pragma("unroll") for (int n = 0; n < 2; ++n) _Pragma("unroll") for (int k = 0; k < 2; ++k) dst[n][k] = *(const LAS bf16x8*)(lds + PG8_SB(b, h) + boff + n * 2048 + k * 1024); } while (0)
#define PG8_MMA(ai, bj, At, Bt) do { __builtin_amdgcn_s_setprio(1); _Pragma("unroll") for (int m = 0; m < 4; ++m) _Pragma("unroll") for (int n = 0; n < 2; ++n) _Pragma("unroll") for (int k = 0; k < 2; ++k) \
        acc[ai][bj][m][n] = __builtin_amdgcn_mfma_f32_16x16x32_bf16(Bt[n][k], At[m][k], acc[ai][bj][m][n], 0, 0, 0); __builtin_amdgcn_s_setprio(0); } while (0)
#define PG8_WAIT_V(n) asm volatile("s_waitcnt vmcnt(" #n ")" ::: "memory")
#define PG8_WAIT_L(n) asm volatile("s_waitcnt lgkmcnt(" #n ")" ::: "memory")
#define PG8_BAR __builtin_amdgcn_s_barrier()
#define PG8_SCHED __builtin_amdgcn_sched_barrier(0)
    Unit cur, nxt; int ui = 0;
    if (!S.next(0, cur)) return;
    f32x4 acc[2][2][4][2];
#pragma unroll
    for (int a = 0; a < 2; ++a)
#pragma unroll
        for (int b = 0; b < 2; ++b)
#pragma unroll
            for (int m = 0; m < 4; ++m)
#pragma unroll
                for (int n = 0; n < 2; ++n) acc[a][b][m][n] = (f32x4){0.f, 0.f, 0.f, 0.f};
    bf16x8 At[4][2], B0[2][2], B1[2][2];
    const char* cA = cur.a; const char* cB = cur.b;
    if (GATHER) { load_gather(cur, gA); }
    PG8_STAGE(PG8_SB(0, 0), cB); PG8_STAGE_A(PG8_SA(0, 0), cA, 0, gA); PG8_STAGE(PG8_SB(0, 1), cB + hstep); PG8_STAGE_A(PG8_SA(0, 1), cA, 1, gA);
    if (wr == 1) PG8_BAR;
    PG8_WAIT_V(4); PG8_BAR;
    PG8_STAGE(PG8_SB(1, 0), cB + kstep); PG8_STAGE_A(PG8_SA(1, 0), cA + kstep, 0, gA); PG8_STAGE(PG8_SB(1, 1), cB + hstep + kstep);
    PG8_WAIT_V(6); PG8_BAR;
    for (;;) {
        const bool has_next = S.next(ui + 1, nxt);
        const char* nA = has_next ? nxt.a : cA; const char* nB = has_next ? nxt.b : cB;

        for (int t = 0; t < nt; t += 2) {
            const bool last = (t == nt - 2);
            const char* a1 = cA + (size_t)(t + 1) * kstep;
            const char* a2 = last ? nA : cA + (size_t)(t + 2) * kstep; const char* b2 = last ? nB : cB + (size_t)(t + 2) * kstep;
            const char* a3 = a2 + kstep; const char* b3 = b2 + kstep;
            PG8_LDB(B0, 0, 0); PG8_SCHED; PG8_LDA(At, 0, 0); PG8_STAGE_A(PG8_SA(1, 1), a1, 1, gA);
            if (GATHER && last && has_next) load_gather(nxt, gA);
            PG8_WAIT_L(8); PG8_BAR; PG8_WAIT_L(0); PG8_MMA(0, 0, At, B0); PG8_BAR; PG8_SCHED;
            PG8_LDB(B1, 0, 1); PG8_STAGE(PG8_SB(0, 0), b2);
            PG8_BAR; PG8_WAIT_L(0); PG8_MMA(0, 1, At, B1); PG8_BAR;
            PG8_LDA(At, 0, 1); PG8_STAGE_A(PG8_SA(0, 0), a2, 0, gA);
            PG8_BAR; PG8_WAIT_L(0); PG8_MMA(1, 0, At, B0); PG8_BAR; PG8_SCHED;
            PG8_STAGE(PG8_SB(0, 1), b2 + hstep);
            PG8_WAIT_V(6); PG8_BAR; PG8_MMA(1, 1, At, B1); PG8_BAR;
            PG8_LDB(B0, 1, 0); PG8_SCHED; PG8_LDA(At, 1, 0); PG8_STAGE_A(PG8_SA(0, 1), a2, 1, gA);
            PG8_WAIT_L(8); PG8_BAR; PG8_WAIT_L(0); PG8_MMA(0, 0, At, B0); PG8_BAR; PG8_SCHED;
            PG8_LDB(B1, 1, 1); PG8_STAGE(PG8_SB(1, 0), b3);
            PG8_BAR; PG8_WAIT_L(0); PG8_MMA(0, 1, At, B1); PG8_BAR;
            PG8_LDA(At, 1, 1); PG8_STAGE_A(PG8_SA(1, 0), a3, 0, gA);
            PG8_BAR; PG8_WAIT_L(0); PG8_MMA(1, 0, At, B0); PG8_BAR; PG8_SCHED;
            PG8_STAGE(PG8_SB(1, 1), b3 + hstep);
            PG8_WAIT_V(6); PG8_BAR; PG8_MMA(1, 1, At, B1); PG8_BAR;
        }
        E(acc, cur, wr, wc, fr, fq);
        if (!has_next) break;
#pragma unroll
        for (int a = 0; a < 2; ++a)
#pragma unroll
            for (int b = 0; b < 2; ++b)
#pragma unroll
                for (int m = 0; m < 4; ++m)
#pragma unroll
                    for (int n = 0; n < 2; ++n) acc[a][b][m][n] = (f32x4){0.f, 0.f, 0.f, 0.f};
        cur = nxt; cA = nA; cB = nB; ++ui;
    }
    PG8_WAIT_V(0);
    if (wr == 0) PG8_BAR;
    PG8_BAR;
#undef PG8_SA
#undef PG8_SB
#undef PG8_STAGE
#undef PG8_STAGE_A
#undef PG8_LDA
#undef PG8_LDB
#undef PG8_MMA
#undef PG8_WAIT_V
#undef PG8_WAIT_L
#undef PG8_BAR
#undef PG8_SCHED
}
}
using pg8::Unit;

struct EpiF32Store {
    float* C; int ldc;
    DEV void operator()(const f32x4 (&acc)[2][2][4][2], const Unit& u, int wr, int wc, int fr, int fq) const {
        const int row0 = u.row0 + wr * 64 + fr, col0 = u.col0 + wc * 32 + 4 * fq;
#pragma unroll
        for (int ai = 0; ai < 2; ++ai)
#pragma unroll
            for (int m = 0; m < 4; ++m) { float* rowp = C + (size_t)(row0 + ai * 128 + m * 16) * ldc + col0;
#pragma unroll
                for (int bj = 0; bj < 2; ++bj)
#pragma unroll
                    for (int n = 0; n < 2; ++n) *(f32x4*)(rowp + bj * 128 + n * 16) = acc[ai][bj][m][n]; }
    }
};
struct EpiQKNorm {
    u16* qkv; const float* gains  ; float* P; char* img;
    DEV void operator()(const f32x4 (&acc)[2][2][4][2], const Unit& u, int wr, int wc, int fr, int fq) const {
        const int c0 = u.col0;
        const int kind = c0 < 1024 ? 0 : c0 < 2048 ? 1 : c0 < 3072 ? 2 : c0 < 4096 ? 3 : c0 < 4352 ? 4 : 5;
        const bool isctx = (u.row0 % RB) == 0;
        const bool normed = (kind == 0 || kind == 1 || kind == 3 || kind == 4);
        const bool wide = kind >= 3;
        if (normed) {
#pragma unroll
            for (int ai = 0; ai < 2; ++ai)
#pragma unroll
                for (int m = 0; m < 4; ++m)
#pragma unroll
                    for (int bj = 0; bj < 2; ++bj) {
                        const f32x4 a = acc[ai][bj][m][0], b = acc[ai][bj][m][1];
                        float ss = a[0] * a[0] + a[1] * a[1] + a[2] * a[2] + a[3] * a[3] + b[0] * b[0] + b[1] * b[1] + b[2] * b[2] + b[3] * b[3];
                        ss += __shfl_xor(ss, 16, 64); ss += __shfl_xor(ss, 32, 64);
                        if (fq == 0) P[(ai * 128 + wr * 64 + m * 16 + fr) * 8 + bj * 4 + wc] = ss;
                    }
        }
        asm volatile("s_waitcnt lgkmcnt(0)" ::: "memory"); __builtin_amdgcn_s_barrier(); asm volatile("" ::: "memory");
        const int row0 = u.row0 + wr * 64 + fr, col0 = c0 + wc * 32 + 4 * fq;
        const float* gp = gains + (kind == 0 ? 0 : kind == 1 ? 128 : kind == 3 ? 256 : 384);
        const int dbase = wide ? (wc * 32 + 4 * fq) : ((wc & 1) * 32 + 4 * fq);
        const float nfi = wide ? (1.f / 32.f) : (1.f / 16.f);
        const bool rowang = wide ? (wc < 2) : ((wc & 1) == 0);
        const float qs = kind == 0 ? 0.125f * LOG2E : kind == 3 ? 0.08838834764831845f * LOG2E : 1.f;
#pragma unroll
        for (int n = 0; n < 2; ++n) {
            float g[4], inv[2];
#pragma unroll
            for (int j = 0; j < 4; ++j) g[j] = normed ? gp[dbase + 16 * n + j] : 1.f;
#pragma unroll
            for (int j2 = 0; j2 < 2; ++j2) { const int f = (wide ? 16 * (wc & 1) : 0) + 8 * n + 2 * fq + j2; inv[j2] = exp2f(-13.287712379549449f * (float)f * nfi); }
#pragma unroll
            for (int ai = 0; ai < 2; ++ai)
#pragma unroll
                for (int m = 0; m < 4; ++m) {
                    const int rl = ai * 128 + wr * 64 + m * 16 + fr, row = row0 + ai * 128 + m * 16;
                    const int pos = (row % RB) - CTXL;
                    const float pa = (float)(rowang ? (pos >> 6) : (pos & 63));
                    u16* rowp = qkv + (size_t)row * AIN + col0 + n * 16;
#pragma unroll
                    for (int bj = 0; bj < 2; ++bj) {
                        float rs = 1.f;
                        if (normed) {
                            const float* pp = P + rl * 8 + bj * 4;
                            const float ss = wide ? (pp[0] + pp[1] + pp[2] + pp[3]) : (pp[wc & 2] + pp[(wc & 2) + 1]);
                            rs = rsqrtf(ss * (wide ? (1.f / 128.f) : (1.f / 64.f)) + EPSN);
                        }
                        const f32x4 v = acc[ai][bj][m][n];
                        float o[4];
#pragma unroll
                        for (int j = 0; j < 4; ++j) o[j] = v[j] * rs * g[j];
                        if (normed && !isctx) {
#pragma unroll
                            for (int j2 = 0; j2 < 2; ++j2) {
                                float sn, cs; __sincosf(pa * inv[j2], &sn, &cs);
                                const float x0 = o[2 * j2], x1 = o[2 * j2 + 1];
                                o[2 * j2] = x0 * cs - x1 * sn; o[2 * j2 + 1] = x0 * sn + x1 * cs;
                            }
                        }
                        u32x2 w; w.x = cvt_pk_bf16(o[0] * qs, o[1] * qs); w.y = cvt_pk_bf16(o[2] * qs, o[3] * qs);
                        const int T = row >> 6, key = row & 63;
                        if (kind == 0 || kind == 3) *(u32x2*)(rowp + bj * 128) = w;
                        else if (kind == 1) {
                            const int sh = ((c0 - 1024) >> 6) + 2 * bj + (wc >> 1), g = 4 * (wc & 1) + 2 * n + (fq >> 1);
                            *(u32x2*)(img + IMG_KD + ((size_t)(sh * NTILE + T) << 13) + ((g * 64 + (key ^ (g & 7))) << 4) + (fq & 1) * 8) = w;
                        } else if (kind == 4) {
                            const int g = 4 * wc + 2 * n + (fq >> 1);
                            *(u32x2*)(img + IMG_KS + ((size_t)(bj * NTILE + T) << 14) + ((g * 64 + (key ^ (g & 7))) << 4) + (fq & 1) * 8) = w;
                        } else {
                            const int hd = kind == 2 ? ((c0 - 2048) >> 7) + bj : bj;
                            char* vb = img + (kind == 2 ? IMG_VD : IMG_VS) + ((size_t)(hd * NTILE + T) << 14);
                            const int kk = key & 15, cidx = 2 * (key >> 4) + ((kk >> 2) & 1), eb = (kk >> 3) * 8 + (kk & 3) * 2;
                            const int d0 = 32 * wc + 16 * n + 4 * fq;
#pragma unroll
                            for (int j = 0; j < 4; ++j) { const int d = d0 + j;
                                *(u16*)(vb + ((cidx * 128 + (d ^ ((d >> 3) & 7))) << 4) + eb) = (u16)((j & 1) ? ((j >> 1 ? w.y : w.x) >> 16) : ((j >> 1 ? w.y : w.x) & 0xffffu)); }
                        }
                    }
                    if (m & 1) __builtin_amdgcn_sched_barrier(0);
                }
        }
    }
};
struct EpiResid {
    const float* xi; float* xo; const float* gmod; const float* bias;
    DEV void operator()(const f32x4 (&acc)[2][2][4][2], const Unit& u, int wr, int wc, int fr, int fq) const {
        const int row0 = u.row0 + wr * 64 + fr, col0 = u.col0 + wc * 32 + 4 * fq;
        const float* gm = gmod + (size_t)(u.row0 / SEQ) * 12288;
        f32x4 gv[2][2], bv[2][2];
#pragma unroll
        for (int bj = 0; bj < 2; ++bj)
#pragma unroll
            for (int n = 0; n < 2; ++n) { gv[bj][n] = *(const f32x4*)(gm + col0 + bj * 128 + n * 16); bv[bj][n] = bias ? *(const f32x4*)(bias + col0 + bj * 128 + n * 16) : (f32x4){0.f, 0.f, 0.f, 0.f}; }
        const float* __restrict__ xin = xi; float* __restrict__ xout = xo;
#pragma unroll
        for (int ai = 0; ai < 2; ++ai)
#pragma unroll
            for (int mp = 0; mp < 2; ++mp) {
                f32x4 xv[2][2][2];
#pragma unroll
                for (int mm = 0; mm < 2; ++mm) { const size_t ro = (size_t)(row0 + ai * 128 + (mp * 2 + mm) * 16) * DM + col0;
#pragma unroll
                    for (int bj = 0; bj < 2; ++bj)
#pragma unroll
                        for (int n = 0; n < 2; ++n) xv[mm][bj][n] = *(const f32x4*)(xin + ro + bj * 128 + n * 16); }
                __builtin_amdgcn_sched_barrier(0);
#pragma unroll
                for (int mm = 0; mm < 2; ++mm) { const int m = mp * 2 + mm; const size_t ro = (size_t)(row0 + ai * 128 + m * 16) * DM + col0;
#pragma unroll
                    for (int bj = 0; bj < 2; ++bj)
#pragma unroll
                        for (int n = 0; n < 2; ++n) *(f32x4*)(xout + ro + bj * 128 + n * 16) = xv[mm][bj][n] + gv[bj][n] * (acc[ai][bj][m][n] + bv[bj][n]); }
            }
    }
};
struct EpiMoe1 {
    u16* act;
    DEV void operator()(const f32x4 (&acc)[2][2][4][2], const Unit& u, int wr, int wc, int fr, int fq) const {
        const int row0 = u.row0 + wr * 64 + fr, col0 = (u.col0 >> 1) + wc * 32 + 4 * fq;
#pragma unroll
        for (int ai = 0; ai < 2; ++ai)
#pragma unroll
            for (int m = 0; m < 4; ++m) { u16* rowp = act + (size_t)(row0 + ai * 128 + m * 16) * FF + col0;
#pragma unroll
                for (int n = 0; n < 2; ++n) { const f32x4 g = acc[ai][0][m][n], up = acc[ai][1][m][n];
                    u32x2 o; o.x = cvt_pk_bf16(silu(g[0]) * up[0], silu(g[1]) * up[1]); o.y = cvt_pk_bf16(silu(g[2]) * up[2], silu(g[3]) * up[3]);
                    *(u32x2*)(rowp + n * 16) = o; } }
    }
};
struct EpiBf16Store {
    u16* O; int ldc; const float* rowbias;
    DEV void operator()(const f32x4 (&acc)[2][2][4][2], const Unit& u, int wr, int wc, int fr, int fq) const {
        const int row0 = u.row0 + wr * 64 + fr, col0 = u.col0 + wc * 32 + 4 * fq;
        float rbv[2][4];
#pragma unroll
        for (int ai = 0; ai < 2; ++ai)
#pragma unroll
            for (int m = 0; m < 4; ++m) rbv[ai][m] = rowbias ? rowbias[row0 + ai * 128 + m * 16] : 0.f;
#pragma unroll
        for (int ai = 0; ai < 2; ++ai)
#pragma unroll
            for (int m = 0; m < 4; ++m) { const int row = row0 + ai * 128 + m * 16; u16* rowp = O + (size_t)row * ldc + col0; const float rb = rbv[ai][m];
#pragma unroll
                for (int bj = 0; bj < 2; ++bj)
#pragma unroll
                    for (int n = 0; n < 2; ++n) { const f32x4 v = acc[ai][bj][m][n];
                        u32x2 o; o.x = cvt_pk_bf16(v[0] + rb, v[1] + rb); o.y = cvt_pk_bf16(v[2] + rb, v[3] + rb);
                        *(u32x2*)(rowp + bj * 128 + n * 16) = o; } }
    }
};
struct EpiFilter {
    float* filtT;
    DEV void operator()(const f32x4 (&acc)[2][2][4][2], const Unit& u, int wr, int wc, int fr, int fq) const {
        const int row0 = u.row0 + wr * 64 + fr, col0 = u.col0 + wc * 32 + 4 * fq;
        const float min_decay = -3.0701134573253946f, max_decay = -15.350567286626973f;
#pragma unroll
        for (int ai = 0; ai < 2; ++ai)
#pragma unroll
            for (int m = 0; m < 4; ++m) { const int row = row0 + ai * 128 + m * 16;
                const float delta = fabsf(min_decay + (max_decay - min_decay) * (float)(row & 2047) / 2047.f) * (1.f / (float)(SEQ - 1));
                float* rowp = filtT + (size_t)row * SEQ + col0;
#pragma unroll
                for (int bj = 0; bj < 2; ++bj)
#pragma unroll
                    for (int n = 0; n < 2; ++n) { const int c = col0 + bj * 128 + n * 16; f32x4 v = acc[ai][bj][m][n];
#pragma unroll
                        for (int j = 0; j < 4; ++j) v[j] *= __expf(-(float)(c + j) * delta);
                        *(f32x4*)(rowp + bj * 128 + n * 16) = v; } }
    }
};

DEV void row_load(const float* p, float4 (&v)[8], int lane) {
#pragma unroll
    for (int i = 0; i < 8; ++i) v[i] = *(const float4*)(p + 4 * lane + 256 * i);
}
DEV float row_rstd(const float4 (&v)[8]) {
    float ss = 0.f;
#pragma unroll
    for (int i = 0; i < 8; ++i) ss += v[i].x * v[i].x + v[i].y * v[i].y + v[i].z * v[i].z + v[i].w * v[i].w;
    ss = wave_sum(ss);
    return rsqrtf(ss * (1.f / DM) + EPSN);
}
DEV void row_modulate(float4 (&v)[8], float rstd, const float* g, const float* sc, const float* sh, int lane) {
#pragma unroll
    for (int i = 0; i < 8; ++i) {
        const int c = 4 * lane + 256 * i;
        const float4 gg = *(const float4*)(g + c), s = *(const float4*)(sc + c), b = *(const float4*)(sh + c);
        v[i].x = v[i].x * rstd * gg.x * (1.f + s.x) + b.x;
        v[i].y = v[i].y * rstd * gg.y * (1.f + s.y) + b.y;
        v[i].z = v[i].z * rstd * gg.z * (1.f + s.z) + b.z;
        v[i].w = v[i].w * rstd * gg.w * (1.f + s.w) + b.w;
    }
}
DEV void row_store_bf16(u16* p, const float4 (&v)[8], int lane) {
#pragma unroll
    for (int i = 0; i < 8; ++i) {
        u32x2 o; o.x = cvt_pk_bf16(v[i].x, v[i].y); o.y = cvt_pk_bf16(v[i].z, v[i].w);
        *(u32x2*)(p + 4 * lane + 256 * i) = o;
    }
}

template <class RM> DEV void conv_tile(const float* src, int N, int k0, int n0, u16* dst, int KP, RM rowmap, float* tl  , int tid_) {
    const int t = tid_;
    {
        const int k = t >> 3, nc = (t & 7) * 8;
        const float4 a = *(const float4*)(src + (size_t)(k0 + k) * N + n0 + nc), b = *(const float4*)(src + (size_t)(k0 + k) * N + n0 + nc + 4);
        float* d = tl + k * 65 + nc;
        d[0] = a.x; d[1] = a.y; d[2] = a.z; d[3] = a.w; d[4] = b.x; d[5] = b.y; d[6] = b.z; d[7] = b.w;
    }
    __syncthreads();
    {
        const int n = t >> 3, kc = (t & 7) * 8;
        const float* s = tl + kc * 65 + n;
        u32x4 o;
        o.x = cvt_pk_bf16(s[0 * 65], s[1 * 65]); o.y = cvt_pk_bf16(s[2 * 65], s[3 * 65]); o.z = cvt_pk_bf16(s[4 * 65], s[5 * 65]); o.w = cvt_pk_bf16(s[6 * 65], s[7 * 65]);
        *(u32x4*)(dst + (size_t)rowmap(n0 + n) * KP + k0 + kc) = o;
    }
    __syncthreads();
}
DEV void convert_moe_layer(const Params& p, char* lds, int layer, int tid_) {
    float* tl = (float*)lds;
    const int per_e = 512 + 512 + 512;
    for (int j = blockIdx.x; j < NEXP * per_e; j += gridDim.x) {
        const int e = j / per_e, r = j % per_e;
        const size_t eo = (size_t)layer * NEXP + e;
        if (r < 1024) {
            const int up = r >= 512, rr = r & 511, kt = rr >> 4, nt = rr & 15;
            const float* src = (up ? p.w_up : p.w_gate) + eo * DM * FF;
            conv_tile(src, FF, kt * 64, nt * 64, p.wt_gu + (size_t)e * 2048 * 2048, 2048, [&](int n) { return ((n >> 7) << 8) + (n & 127) + (up ? 128 : 0); }, tl, tid_);
        } else {
            const int rr = r - 1024, kt = rr >> 5, nt = rr & 31;
            conv_tile(p.w_down + eo * FF * DM, DM, kt * 64, nt * 64, p.wt_dn + (size_t)e * 2048 * 1024, 1024, [&](int n) { return n; }, tl, tid_);
        }
    }
}
struct CvtBlk {
    float4 v[8]; u16* dst; unsigned dstride;
    DEV void issue(const float* src, unsigned N, u16* dstm, unsigned KP, unsigned w) {
        const unsigned nb8 = N >> 5, rest = w >> 6, k8 = (w & 7u) | ((rest / nb8) << 3), n4 = ((w >> 3) & 7u) | ((rest % nb8) << 3);
        const float* sp = src + (size_t)(k8 * 8u) * N + n4 * 4u;
        dst = dstm + (size_t)(n4 * 4u) * KP + k8 * 8u; dstride = KP;
#pragma unroll
        for (int j = 0; j < 8; ++j) { const f32x4 q_ = __builtin_nontemporal_load((const f32x4*)(sp + (size_t)j * N)); v[j] = make_float4(q_[0], q_[1], q_[2], q_[3]); }
    }
    DEV void finish() {
        u32x4 o;
        o.x = cvt_pk_bf16(v[0].x, v[1].x); o.y = cvt_pk_bf16(v[2].x, v[3].x); o.z = cvt_pk_bf16(v[4].x, v[5].x); o.w = cvt_pk_bf16(v[6].x, v[7].x); __builtin_nontemporal_store(o, (u32x4*)(dst));
        o.x = cvt_pk_bf16(v[0].y, v[1].y); o.y = cvt_pk_bf16(v[2].y, v[3].y); o.z = cvt_pk_bf16(v[4].y, v[5].y); o.w = cvt_pk_bf16(v[6].y, v[7].y); __builtin_nontemporal_store(o, (u32x4*)(dst + dstride));
        o.x = cvt_pk_bf16(v[0].z, v[1].z); o.y = cvt_pk_bf16(v[2].z, v[3].z); o.z = cvt_pk_bf16(v[4].z, v[5].z); o.w = cvt_pk_bf16(v[6].z, v[7].z); __builtin_nontemporal_store(o, (u32x4*)(dst + 2 * dstride));
        o.x = cvt_pk_bf16(v[0].w, v[1].w); o.y = cvt_pk_bf16(v[2].w, v[3].w); o.z = cvt_pk_bf16(v[4].w, v[5].w); o.w = cvt_pk_bf16(v[6].w, v[7].w); __builtin_nontemporal_store(o, (u32x4*)(dst + 3 * dstride));
    }
};
DEV void cvt_dense_matrix(const float* src, unsigned K, unsigned N, u16* dst, unsigned KP, unsigned gtid, unsigned gstride) {
    const unsigned nblk = (K >> 3) * (N >> 2);
    CvtBlk a, b, c;
    unsigned w = gtid;
#pragma unroll 1
    for (; w + 2 * gstride < nblk; w += 3 * gstride) { a.issue(src, N, dst, KP, w); b.issue(src, N, dst, KP, w + gstride); c.issue(src, N, dst, KP, w + 2 * gstride); a.finish(); b.finish(); c.finish(); }
#pragma unroll 1
    for (; w < nblk; w += gstride) { a.issue(src, N, dst, KP, w); a.finish(); }
}
DEV void convert_dense(const Params& p, char* lds, int tid_) {
    const unsigned gtid = blockIdx.x * NTHR + tid_, gstride = gridDim.x * NTHR;
    cvt_dense_matrix(p.attn_w_in, DM, AIN, p.wt_attn_in, DM, gtid, gstride);
    cvt_dense_matrix(p.attn_w_out, DM, DM, p.wt_attn_out, DM, gtid, gstride);
    cvt_dense_matrix(p.hy_w_in, DM, 6144, p.wt_hy_in, DM, gtid, gstride);
    cvt_dense_matrix(p.hy_w_out, DM, DM, p.wt_hy_out, DM, gtid, gstride);
    cvt_dense_matrix(p.flt_w3, 64, 8192, p.wt_w3, 256, gtid, gstride);
    for (int i = blockIdx.x * NTHR + tid_; i < 8192 * 24; i += gridDim.x * NTHR) {
        const int row = i / 24, ch = i % 24;
        *(u32x4*)(p.wt_w3 + (size_t)row * 256 + 64 + ch * 8) = (u32x4){0u, 0u, 0u, 0u};
    }
}

struct CvtJob {
    float4 v[8]; u16* dst; unsigned dstride;
    DEV void issue(const Params& p, int layer, unsigned id) {
        if (id >= NEXP * 3u * 65536u) id = NEXP * 3u * 65536u - 1u;
        const unsigned me = id >> 16, w = id & 65535u, e = me / 3u, mat = me - 3u * e;
        const size_t eo = (size_t)layer * NEXP + e;
        const float* src; unsigned ldn;
        if (mat < 2u) { const unsigned k8 = (w & 7u) | ((w >> 11) << 3), n4 = ((w >> 3) & 7u) | (((w >> 6) & 31u) << 3), n = n4 * 4u;
            src = (mat ? p.w_up : p.w_gate) + eo * DM * FF + (size_t)(k8 * 8u) * FF + n; ldn = FF;
            dst = p.wt_gu + (size_t)e * 2048 * 2048 + (size_t)(((n >> 7) << 8) + (n & 127u) + (mat ? 128u : 0u)) * 2048 + k8 * 8u; dstride = 2048; }
        else { const unsigned k8 = (w & 7u) | ((w >> 12) << 3), n4 = ((w >> 3) & 7u) | (((w >> 6) & 63u) << 3), n = n4 * 4u;
            src = p.w_down + eo * FF * DM + (size_t)(k8 * 8u) * DM + n; ldn = DM;
            dst = p.wt_dn + (size_t)e * 2048 * 1024 + (size_t)n * 1024 + k8 * 8u; dstride = 1024; }
#pragma unroll
        for (int j = 0; j < 8; ++j) { const f32x4 q_ = __builtin_nontemporal_load((const f32x4*)(src + (size_t)j * ldn)); v[j] = make_float4(q_[0], q_[1], q_[2], q_[3]); }
    }
    DEV void finish() {
        u32x4 o;
        o.x = cvt_pk_bf16(v[0].x, v[1].x); o.y = cvt_pk_bf16(v[2].x, v[3].x); o.z = cvt_pk_bf16(v[4].x, v[5].x); o.w = cvt_pk_bf16(v[6].x, v[7].x); __builtin_nontemporal_store(o, (u32x4*)(dst));
        o.x = cvt_pk_bf16(v[0].y, v[1].y); o.y = cvt_pk_bf16(v[2].y, v[3].y); o.z = cvt_pk_bf16(v[4].y, v[5].y); o.w = cvt_pk_bf16(v[6].y, v[7].y); __builtin_nontemporal_store(o, (u32x4*)(dst + dstride));
        o.x = cvt_pk_bf16(v[0].z, v[1].z); o.y = cvt_pk_bf16(v[2].z, v[3].z); o.z = cvt_pk_bf16(v[4].z, v[5].z); o.w = cvt_pk_bf16(v[6].z, v[7].z); __builtin_nontemporal_store(o, (u32x4*)(dst + 2 * dstride));
        o.x = cvt_pk_bf16(v[0].w, v[1].w); o.y = cvt_pk_bf16(v[2].w, v[3].w); o.z = cvt_pk_bf16(v[4].w, v[5].w); o.w = cvt_pk_bf16(v[6].w, v[7].w); __builtin_nontemporal_store(o, (u32x4*)(dst + 3 * dstride));
    }
};
constexpr unsigned CVT_ROUTE_JOBS0 = 16;
constexpr unsigned CVT_ROUTE_JOBS = 16;
DEV void phase_prologue(const Params& p, char* lds, int tid_) {
    const int t = tid_, lane = t & 63, w = t >> 6;
    const int G = gridDim.x, bid = blockIdx.x;
    if (bid == 0 && t < 64) p.cnt[t] = 0u;
    if (bid == 1 && t < 128) { p.gains[t] = t < 64 ? p.diff_q_g[t] : 0.f; p.gains[128 + t] = t < 64 ? p.diff_k_g[t] : 0.f; p.gains[256 + t] = p.swa_q_g[t]; p.gains[384 + t] = p.swa_k_g[t]; }
    if (bid < 192) {
        float* s = (float*)lds;
        float* part = (float*)(lds + 40960);
        float cv[5 * DM / NTHR];
#pragma unroll
        for (int q = 0; q < 5 * DM / NTHR; ++q) { const int r = q / (DM / NTHR), k = (q % (DM / NTHR)) * NTHR + t; cv[q] = r < 4 ? p.c[r * DM + k] : p.c_ctx[k]; }
#pragma unroll
        for (int q = 0; q < 5 * DM / NTHR; ++q) s[q * NTHR + t] = silu(cv[q]);
        __syncthreads();
        for (int u = bid; u < 192; u += G) {
            const int layer = u / 96, col = (u % 96) * 128 + 2 * lane;
            const float* W = p.ada_w + (size_t)layer * DM * 12288 + col;
            float acc[5][2];
#pragma unroll
            for (int r = 0; r < 5; ++r) { acc[r][0] = 0.f; acc[r][1] = 0.f; }
            const int k0 = w * 256;
            for (int k = k0; k < k0 + 256; k += 16) {
                float2 wv[16];
#pragma unroll
                for (int j = 0; j < 16; ++j) wv[j] = *(const float2*)(W + (size_t)(k + j) * 12288);
#pragma unroll
                for (int j = 0; j < 16; ++j)
#pragma unroll
                    for (int r = 0; r < 5; ++r) { const float sv = s[r * DM + k + j]; acc[r][0] += sv * wv[j].x; acc[r][1] += sv * wv[j].y; }
            }
#pragma unroll
            for (int r = 0; r < 5; ++r) { part[(w * 5 + r) * 128 + 2 * lane] = acc[r][0]; part[(w * 5 + r) * 128 + 2 * lane + 1] = acc[r][1]; }
            __syncthreads();
            if (t < 128) {
                const int cc = (u % 96) * 128 + t;
                const float bias = p.ada_b[layer * 12288 + cc];
#pragma unroll
                for (int r = 0; r < 5; ++r) {
                    float sum = bias;
#pragma unroll
                    for (int ww = 0; ww < 8; ++ww) sum += part[(ww * 5 + r) * 128 + t];
                    p.mod[((size_t)layer * 5 + r) * 12288 + cc] = sum;
                }
            }
            __syncthreads();
        }
    }
    for (int j = bid * NTHR + t; j < 8192; j += G * NTHR) {
        float sn, cs; sincospif((float)j * (2.f / 8192.f), &sn, &cs);
        p.tw[j] = make_float2(cs, -sn);
        if (j < 4096) { const int k = j >> 8, tt = j & 255; sincospif((float)((tt * k) & 4095) * (2.f / 4096.f), &sn, &cs); p.tw[8192 + j] = make_float2(cs, -sn); }
        if (j < 256)  { const int k = j >> 4, jj = j & 15;  sincospif((float)((jj * k) & 255) * (2.f / 256.f), &sn, &cs);  p.tw[12288 + j] = make_float2(cs, -sn); }
    }
    {
        __syncthreads();
        float* a1s = (float*)lds;
        const int u = lane, sub = w;
        for (int n0 = bid * 8; n0 < SEQ; n0 += G * 8) {
            const int n = n0 + sub;
            const float tt = (float)n / (float)(SEQ - 1);
            const float wv = 6.283185307179586f * (float)n / (float)SEQ;
            float acc = p.flt_b1[u] + tt * p.flt_w1[0 * 64 + u];
#pragma unroll
            for (int j = 0; j < 16; ++j) {
                const float f = 1e-4f + (float)j * ((15.f - 1e-4f) / 15.f);
                const float a = wv * f;
                acc += cosf(a) * p.flt_w1[(1 + j) * 64 + u] - sinf(a) * p.flt_w1[(17 + j) * 64 + u];
            }
            const float a1 = sinf(p.flt_f1[u] * acc);
            __syncthreads();
            a1s[sub * 64 + u] = a1;
            __syncthreads();
            float acc2 = p.flt_b2[u];
#pragma unroll 8
            for (int v = 0; v < 64; ++v) acc2 += a1s[sub * 64 + v] * p.flt_w2[v * 64 + u];
            p.a2p[n * 256 + u] = f2bf(sinf(p.flt_f2[u] * acc2));
            p.a2p[n * 256 + 64 + u] = 0; p.a2p[n * 256 + 128 + u] = 0; p.a2p[n * 256 + 192 + u] = 0;
        }
        __syncthreads();
    }
    convert_dense(p, lds, tid_);
    {
        const unsigned gtid = blockIdx.x * NTHR + tid_, gstride = gridDim.x * NTHR, njobs = (NEXP * 3u * 65536u + gstride - 1u) / gstride;
        CvtJob ja, jb, jc;
        unsigned j = CVT_ROUTE_JOBS;
#pragma unroll 1
        for (; j + 3 <= njobs; j += 3) { ja.issue(p, 0, j * gstride + gtid); jb.issue(p, 0, (j + 1) * gstride + gtid); jc.issue(p, 0, (j + 2) * gstride + gtid); ja.finish(); jb.finish(); jc.finish(); }
#pragma unroll 1
        for (; j < njobs; ++j) { ja.issue(p, 0, j * gstride + gtid); ja.finish(); }
    }
}

DEV void phase_norm1_l0(const Params& p, int tid_) {
    const int lane = tid_ & 63, w = tid_ >> 6;
    for (int rr = blockIdx.x * NW + w; rr < NROW; rr += gridDim.x * NW) {
        const int b = rr / RB, i = rr % RB;
        const float* src = i < CTXL ? p.ctx + ((size_t)b * CTXL + i) * DM : p.x + ((size_t)b * SEQ + (i - CTXL)) * DM;
        const float* md = p.mod + (size_t)(i < CTXL ? 4 : b) * 12288;
        float4 v[8]; row_load(src, v, lane);
        const float rstd = row_rstd(v);
        row_modulate(v, rstd, p.norm1_g, md + 2048, md, lane);
        row_store_bf16(p.h + (size_t)rr * DM, v, lane);
    }
}

DEV void phase_qknorm(const Params& p, int tid_) {
    const int lane = tid_ & 63, w = tid_ >> 6;
    const u16* raw = (const u16*)p.regA; u16* qkv = p.regB;
    for (int rr = blockIdx.x; rr < NROW; rr += gridDim.x) {
        const int i = rr % RB;
        const bool isctx = i < CTXL;
        const int pos = i - CTXL, prow = pos >> 6, pcol = pos & 63;
        for (int st = w; st < 36; st += NW) {
            const int c0 = st * 128;
            const int kind = c0 < 1024 ? 0 : c0 < 2048 ? 1 : c0 < 3072 ? 2 : c0 < 4096 ? 3 : c0 < 4352 ? 4 : 5;
            if (isctx && (kind == 0 || kind == 3)) continue;
            const unsigned rv_ = *(const unsigned*)(raw + (size_t)rr * AIN + c0 + 2 * lane);
            const float2 v = make_float2(__builtin_bit_cast(float, rv_ << 16), __builtin_bit_cast(float, rv_ & 0xffff0000u));
            float o0 = v.x, o1 = v.y;
            if (kind == 0 || kind == 1) {
                float ss = v.x * v.x + v.y * v.y;
#pragma unroll
                for (int m = 16; m >= 1; m >>= 1) ss += __shfl_xor(ss, m, 64);
                const float rs = rsqrtf(ss * (1.f / 64.f) + EPSN);
                const float* g = (kind == 0 ? p.diff_q_g : p.diff_k_g) + 2 * (lane & 31);
                o0 = v.x * rs * g[0]; o1 = v.y * rs * g[1];
                if (!isctx) {
                    const int pi = lane & 31;
                    const float inv = exp2f(-13.287712379549449f * (float)(pi & 15) * (1.f / 16.f));
                    const float ang = (float)(pi < 16 ? prow : pcol) * inv;
                    float sn, cs; __sincosf(ang, &sn, &cs);
                    const float a = o0 * cs - o1 * sn, b = o0 * sn + o1 * cs;
                    o0 = a; o1 = b;
                }
                if (kind == 0) { o0 *= 0.125f * LOG2E; o1 *= 0.125f * LOG2E; }
            } else if (kind == 3 || kind == 4) {
                float ss = wave_sum(v.x * v.x + v.y * v.y);
                const float rs = rsqrtf(ss * (1.f / 128.f) + EPSN);
                const float* g = (kind == 3 ? p.swa_q_g : p.swa_k_g) + 2 * lane;
                o0 = v.x * rs * g[0]; o1 = v.y * rs * g[1];
                if (!isctx) {
                    const int pi = lane;
                    const float inv = exp2f(-13.287712379549449f * (float)(pi & 31) * (1.f / 32.f));
                    const float ang = (float)(pi < 32 ? prow : pcol) * inv;
                    float sn, cs; __sincosf(ang, &sn, &cs);
                    const float a = o0 * cs - o1 * sn, b = o0 * sn + o1 * cs;
                    o0 = a; o1 = b;
                }
                if (kind == 3) { o0 *= 0.08838834764831845f * LOG2E; o1 *= 0.08838834764831845f * LOG2E; }
            }
            *(unsigned*)(qkv + (size_t)rr * AIN + c0 + 2 * lane) = cvt_pk_bf16(o0, o1);
        }
    }
}

constexpr int AT_STAGE = 32768, AT_VOFF = 16384;
template <int DQK, bool SWA>
DEV void attn_item(const Params& p, char* lds  , int tl, int sub, int item, float M2, float sink_term_l2, float lam, unsigned (&park)[32]) {
    const int t = tl, lane = t & 63, w = t >> 6, r = lane & 31, h = lane >> 5;
    const u16* qkv = p.regB;
    int b, qb, qcol, kcol, vcol, hs;
    if (!SWA) { qb = (item >> 1) & 31; hs = ((item >> 6) & 7) * 2 + (item & 1); b = item >> 9; qcol = hs * 64; kcol = 1024 + hs * 64; vcol = 2048 + (hs >> 1) * 128; }
    else      { qb = item & 31; hs = (item >> 5) & 7;  b = item >> 8; qcol = 3072 + hs * 128; kcol = 4096 + (hs >> 2) * 128; vcol = 4352 + (hs >> 2) * 128; }
    const size_t brow = (size_t)b * RB;
    int ntile, lo = 0;
    if (!SWA) ntile = RB / 64;
    else { lo = qb * 128 - 128; if (lo < 0) lo = 0; if (lo > SEQ - 384) lo = SEQ - 384; ntile = 10; }
    const char* kimg = (const char*)p.regA + (SWA ? IMG_KS + ((size_t)((hs >> 2) * NTILE) << 14) : IMG_KD + ((size_t)(hs * NTILE) << 13));
    const char* vimg = (const char*)p.regA + (SWA ? IMG_VS + ((size_t)((hs >> 2) * NTILE) << 14) : IMG_VD + ((size_t)((hs >> 1) * NTILE) << 14));
    auto tile_idx = [&](int kt) -> int { if (!SWA) return b * (RB / 64) + kt; return kt < 4 ? b * (RB / 64) + kt : b * (RB / 64) + 4 + (lo >> 6) + (kt - 4); };
    const int ts = SWA ? t : t + sub * 256;
    const int wbase = (ts & ~63) * 16;
    constexpr int PROW = SWA ? 4096 : 8192;
    auto stage = [&](int kt, char* st) {
        const int T = tile_idx(kt);
        const char* kg = kimg + ((size_t)T * (DQK * 128)) + ts * 16;
        const char* vg = vimg + ((size_t)T << 14) + ts * 16;
#pragma unroll
        for (int i = 0; i < DQK * 128 / PROW; ++i) __builtin_amdgcn_global_load_lds((const unsigned*)(kg + i * PROW), (LAS unsigned*)(st + i * PROW + wbase), 16, 0, 0);
#pragma unroll
        for (int i = 0; i < 16384 / PROW; ++i) __builtin_amdgcn_global_load_lds((const unsigned*)(vg + i * PROW), (LAS unsigned*)(st + AT_VOFF + i * PROW + wbase), 16, 0, 0);
    };
    const int qpos = qb * 128 + w * 32 + r;
    const u16* qp = qkv + (brow + CTXL + qpos) * AIN + qcol + 8 * h;
    bf16x8 qf[DQK / 16];
#pragma unroll
    for (int ks = 0; ks < DQK / 16; ++ks) qf[ks] = *(const bf16x8*)(qp + 16 * ks);
    int kb4[4], vb2[2];
#pragma unroll
    for (int j = 0; j < 4; ++j) kb4[j] = ((r ^ (2 * j + h)) << 4) + 1024 * h;
#pragma unroll
    for (int j = 0; j < 2; ++j) vb2[j] = ((r ^ (4 * j + (r >> 3))) << 4) + 2048 * h;
    f32x16 O[4];
#pragma unroll
    for (int i = 0; i < 4; ++i)
#pragma unroll
        for (int e = 0; e < 16; ++e) O[i][e] = 0.f;
    float lsum = 0.f;
    constexpr int NST = SWA ? 2 : 4, PD = NST - 1;
    __syncthreads();
#pragma unroll
    for (int d = 0; d < PD; ++d) stage(d, lds + d * AT_STAGE);
    if (SWA) asm volatile("s_waitcnt vmcnt(0)" ::: "memory"); else asm volatile("s_waitcnt vmcnt(6)" ::: "memory");
    __builtin_amdgcn_s_barrier();
    for (int kt = 0; kt < ntile; ++kt) {
        char* cur = lds + (kt & (NST - 1)) * AT_STAGE;
        if (kt + PD < ntile) stage(kt + PD, lds + ((kt + PD) & (NST - 1)) * AT_STAGE);
        __builtin_amdgcn_sched_barrier(0);
        const bool local = SWA && kt >= 4;
        const int kpos0 = local ? lo + (kt - 4) * 64 : 0;
        if (!SWA) {
            f32x16 S0, S1;
#pragma unroll
            for (int e = 0; e < 16; ++e) { S0[e] = -M2; S1[e] = -M2; }
#pragma unroll
            for (int ks = 0; ks < DQK / 16; ++ks) {
                const bf16x8 k0 = *(const bf16x8*)(cur + kb4[ks & 3] + (2048 * ks));
                const bf16x8 k1 = *(const bf16x8*)(cur + kb4[ks & 3] + (2048 * ks + 512));
                S0 = mfma32(k0, qf[ks], S0); S1 = mfma32(k1, qf[ks], S1);
            }
#pragma unroll
            for (int e = 0; e < 16; ++e) { S0[e] = __builtin_amdgcn_exp2f(S0[e]); lsum += S0[e]; }
#pragma unroll
            for (int s2 = 0; s2 < 2; ++s2) {
                const int a = s2 * 8;
                u32x4 pk;
                pk.x = cvt_pk_bf16n(S0[a + 0], S0[a + 1]); pk.y = cvt_pk_bf16n(S0[a + 2], S0[a + 3]);
                pk.z = cvt_pk_bf16n(S0[a + 4], S0[a + 5]); pk.w = cvt_pk_bf16n(S0[a + 6], S0[a + 7]);
                const bf16x8 pf = __builtin_bit_cast(bf16x8, pk);
#pragma unroll
                for (int md = 0; md < 4; ++md) {
                    const bf16x8 vf = *(const bf16x8*)(cur + AT_VOFF + vb2[md & 1] + (512 * md + 4096 * s2));
                    O[md] = mfma32(vf, pf, O[md]);
                }
#pragma unroll
                for (int e = a; e < a + 8; ++e) { S1[e] = __builtin_amdgcn_exp2f(S1[e]); lsum += S1[e]; }
            }
#pragma unroll
            for (int s2 = 0; s2 < 2; ++s2) {
                const int a = s2 * 8;
                u32x4 pk;
                pk.x = cvt_pk_bf16n(S1[a + 0], S1[a + 1]); pk.y = cvt_pk_bf16n(S1[a + 2], S1[a + 3]);
                pk.z = cvt_pk_bf16n(S1[a + 4], S1[a + 5]); pk.w = cvt_pk_bf16n(S1[a + 6], S1[a + 7]);
                const bf16x8 pf = __builtin_bit_cast(bf16x8, pk);
#pragma unroll
                for (int md = 0; md < 4; ++md) {
                    const bf16x8 vf = *(const bf16x8*)(cur + AT_VOFF + vb2[md & 1] + (512 * md + 4096 * (2 + s2)));
                    O[md] = mfma32(vf, pf, O[md]);
                }
            }
        } else
#pragma unroll
        for (int mk = 0; mk < 2; ++mk) {
            f32x16 S;
#pragma unroll
            for (int e = 0; e < 16; ++e) S[e] = -M2;
#pragma unroll
            for (int ks = 0; ks < DQK / 16; ++ks) {
                const bf16x8 kf = *(const bf16x8*)(cur + kb4[ks & 3] + (2048 * ks + 512 * mk));
                S = mfma32(kf, qf[ks], S);
            }
#pragma unroll
            for (int e = 0; e < 16; ++e) {
                float pv = __builtin_amdgcn_exp2f(S[e]);
                if (SWA) {
                    if (local) {
                        const int kp = kpos0 + mk * 32 + (e & 3) + 8 * (e >> 2) + 4 * h;
                        const int df = kp - qpos;
                        if (df > 128 || df < -128) pv = 0.f;
                    }
                }
                S[e] = pv; lsum += pv;
            }
#pragma unroll
            for (int s2 = 0; s2 < 2; ++s2) {
                const int a = s2 * 8;
                u32x4 pk;
                pk.x = cvt_pk_bf16n(S[a + 0], S[a + 1]); pk.y = cvt_pk_bf16n(S[a + 2], S[a + 3]);
                pk.z = cvt_pk_bf16n(S[a + 4], S[a + 5]); pk.w = cvt_pk_bf16n(S[a + 6], S[a + 7]);
                const bf16x8 pf = __builtin_bit_cast(bf16x8, pk);
#pragma unroll
                for (int md = 0; md < 4; ++md) {
                    const bf16x8 vf = *(const bf16x8*)(cur + AT_VOFF + vb2[md & 1] + (512 * md + 4096 * (mk * 2 + s2)));
                    O[md] = mfma32(vf, pf, O[md]);
                }
            }
            if (SWA) __builtin_amdgcn_sched_barrier(0);
        }
        if (!SWA && kt + PD < ntile) asm volatile("s_waitcnt vmcnt(6)" ::: "memory");
        else asm volatile("s_waitcnt vmcnt(0)" ::: "memory");
        asm volatile("s_waitcnt lgkmcnt(0)" ::: "memory");
        __builtin_amdgcn_s_barrier();
    }
    float l = lsum + __shfl_xor(lsum, 32, 64);
    if (SWA) l += sink_term_l2;
    const float inv = 1.f / l;
    const size_t tok = (size_t)b * SEQ + qpos;
#pragma unroll
    for (int md = 0; md < 4; ++md)
#pragma unroll
        for (int rq = 0; rq < 4; ++rq) {
            const int d0 = md * 32 + 8 * rq + 4 * h;
            const float o0 = O[md][rq * 4 + 0] * inv, o1 = O[md][rq * 4 + 1] * inv, o2 = O[md][rq * 4 + 2] * inv, o3 = O[md][rq * 4 + 3] * inv;
            if (SWA) { u32x2 o; o.x = cvt_pk_bf16(o0, o1); o.y = cvt_pk_bf16(o2, o3); *(u32x2*)(p.attn_out + tok * DM + 1024 + hs * 128 + d0) = o; }
            else if ((hs & 1) == 0) { park[(md * 4 + rq) * 2] = cvt_pk_bf16(o0, o1); park[(md * 4 + rq) * 2 + 1] = cvt_pk_bf16(o2, o3); }
            else { O[md][rq * 4 + 0] = o0; O[md][rq * 4 + 1] = o1; O[md][rq * 4 + 2] = o2; O[md][rq * 4 + 3] = o3; }
        }
    if (!SWA && (hs & 1)) {
        float ss = 0.f;
#pragma unroll
        for (int md = 0; md < 4; ++md)
#pragma unroll
            for (int rq = 0; rq < 4; ++rq) {
                const unsigned pa = park[(md * 4 + rq) * 2], pb = park[(md * 4 + rq) * 2 + 1];
                const float ax = __builtin_bit_cast(float, pa << 16), ay = __builtin_bit_cast(float, pa & 0xffff0000u), az = __builtin_bit_cast(float, pb << 16), aw = __builtin_bit_cast(float, pb & 0xffff0000u);
                const float e0 = ax - lam * O[md][rq * 4 + 0], e1 = ay - lam * O[md][rq * 4 + 1], e2 = az - lam * O[md][rq * 4 + 2], e3 = aw - lam * O[md][rq * 4 + 3];
                O[md][rq * 4 + 0] = e0; O[md][rq * 4 + 1] = e1; O[md][rq * 4 + 2] = e2; O[md][rq * 4 + 3] = e3;
                ss += e0 * e0 + e1 * e1 + e2 * e2 + e3 * e3;
            }
        ss += __shfl_xor(ss, 32, 64);
        const float rs = rsqrtf(ss * (1.f / 128.f) + EPSN) * 0.8f;
        float4 gq[4][4];
#pragma unroll
        for (int md = 0; md < 4; ++md)
#pragma unroll
            for (int rq = 0; rq < 4; ++rq) gq[md][rq] = *(const float4*)(p.diff_sub_g + md * 32 + 8 * rq + 4 * h);
#pragma unroll
        for (int md = 0; md < 4; ++md)
#pragma unroll
            for (int rq = 0; rq < 4; ++rq) {
                const int d0 = md * 32 + 8 * rq + 4 * h;
                const float4 g = gq[md][rq];
                u32x2 o; o.x = cvt_pk_bf16(O[md][rq * 4 + 0] * rs * g.x, O[md][rq * 4 + 1] * rs * g.y); o.y = cvt_pk_bf16(O[md][rq * 4 + 2] * rs * g.z, O[md][rq * 4 + 3] * rs * g.w);
                *(u32x2*)(p.attn_out + tok * DM + (hs >> 1) * 128 + d0) = o;
            }
    }
}
DEV void phase_attention(const Params& p, char* lds, int tid_) {
    const int lane = tid_ & 63, sub = __builtin_amdgcn_readfirstlane(tid_ >> 8), tl = tid_ & 255;
    char* ldsb = lds + sub * 65536;
    const float mq = wave_max(fabsf(p.diff_q_g[lane])), mk = wave_max(fabsf(p.diff_k_g[lane]));
    const float M2d = LOG2E * mq * 8.f * mk * 1.02f;
    const float msq = wave_max(fmaxf(fabsf(p.swa_q_g[lane]), fabsf(p.swa_q_g[lane + 64])));
    const float msk = wave_max(fmaxf(fabsf(p.swa_k_g[lane]), fabsf(p.swa_k_g[lane + 64])));
    const float M2s = LOG2E * msq * 11.313708498984761f * msk * 1.02f;
#ifndef ATT_ONLY
#define ATT_ONLY 3
#endif
    const float lam = expf(wave_sum(p.lq1[lane] * p.lk1[lane])) - expf(wave_sum(p.lq2[lane] * p.lk2[lane])) + 0.2f;
    if (ATT_ONLY & 1) for (int it0 = blockIdx.x; it0 < 512; it0 += gridDim.x) {
        const int it = (((it0 >> 8) * 8 + (it0 & 7)) * 2 + ((it0 >> 7) & 1)) * 16 + ((it0 >> 3) & 15);
        unsigned park[32];
#pragma unroll
        for (int i = 0; i < 32; ++i) park[i] = 0u;
        attn_item<64, false>(p, lds, tl, sub, (2 * it + sub) * 2 + 0, M2d, 0.f, lam, park);
        attn_item<64, false>(p, lds, tl, sub, (2 * it + sub) * 2 + 1, M2d, 0.f, lam, park);
    }
    if (ATT_ONLY & 2) for (int it0 = blockIdx.x; it0 < 512; it0 += gridDim.x) {
        const int it = (((it0 >> 8) * 8 + (it0 & 7)) * 2 + ((it0 >> 7) & 1)) * 16 + ((it0 >> 3) & 15);
        const int item = 2 * it + sub, j = (item >> 5) & 7;
        unsigned dummy[32]; attn_item<128, true>(p, ldsb, tl, sub, item, M2s, __builtin_amdgcn_exp2f(p.swa_sink[j] * LOG2E - M2s), 0.f, dummy);
    }
}

DEV void phase_norm2_route(const Params& p, char* lds, int layer, const float* xin, int tid_) {
    const int t = tid_, lane = t & 63, w = t >> 6;
    const unsigned nrj = layer == 0 ? CVT_ROUTE_JOBS : 0u;
    unsigned* te = (unsigned*)(lds);
    unsigned* lcnt = (unsigned*)(lds + 1024);
    unsigned* lrk = (unsigned*)(lds + 2048);
    const float* wg1 = p.wg1 + (size_t)layer * DM * 4;
    const float* wg2 = p.wg2 + (size_t)layer * DM * 32;
    for (int rb = blockIdx.x * 64; rb < NTOK; rb += gridDim.x * 64) {
        if (t < 32) lcnt[t] = 0u;
        __syncthreads();
        const int bidx = rb / SEQ;
        const float* md = p.mod + ((size_t)layer * 5 + bidx) * 12288;
#pragma unroll 1
        for (int j = 0; j < 4; ++j) {
            const int r0 = rb + 8 * w + 2 * j;
            float4 v0[8], v1[8];
            int lq = lane; asm volatile("" : "+v"(lq));
            row_load(xin + (size_t)r0 * DM, v0, lq); row_load(xin + (size_t)(r0 + 1) * DM, v1, lq);
            CvtJob ja, jb;
            const unsigned gtid = blockIdx.x * NTHR + tid_, gstride = gridDim.x * NTHR;
            const unsigned j0 = (unsigned)j * 4u;
            if (j0 + 1 < nrj) { ja.issue(p, layer, j0 * gstride + gtid); jb.issue(p, layer, (j0 + 1) * gstride + gtid); }
            const float rs0 = row_rstd(v0), rs1 = row_rstd(v1);
            row_modulate(v0, rs0, p.norm2_g + layer * DM, md + 8192, md + 6144, lq);
            __builtin_amdgcn_sched_barrier(0);
            row_modulate(v1, rs1, p.norm2_g + layer * DM, md + 8192, md + 6144, lq);
            __builtin_amdgcn_sched_barrier(0);
            row_store_bf16(p.h2 + (size_t)r0 * DM, v0, lq); row_store_bf16(p.h2 + (size_t)(r0 + 1) * DM, v1, lq);
            __builtin_amdgcn_sched_barrier(0);
            float* xs = (float*)(lds + 8192) + w * 4096;
#pragma unroll
            for (int i = 0; i < 8; ++i) { *(float4*)(xs + 4 * lq + 256 * i) = v0[i]; *(float4*)(xs + 2048 + 4 * lq + 256 * i) = v1[i]; }
            __builtin_amdgcn_sched_barrier(0);
            float* lg = (float*)(lds + 4096) + w * 72;
            {
                const int kk = lq >> 3, q = lq & 7;
                float e0[4] = {0.f, 0.f, 0.f, 0.f}, e1[4] = {0.f, 0.f, 0.f, 0.f};
                const float* wp = wg2 + (unsigned)(kk * 32 + 4 * q);
#pragma unroll 16
                for (int it = 0; it < 256; ++it) {
                    const float4 wv = *(const float4*)(wp + (unsigned)(it * 256));
                    const float xa = xs[8 * it + kk], xb = xs[2048 + 8 * it + kk];
                    e0[0] += xa * wv.x; e0[1] += xa * wv.y; e0[2] += xa * wv.z; e0[3] += xa * wv.w;
                    e1[0] += xb * wv.x; e1[1] += xb * wv.y; e1[2] += xb * wv.z; e1[3] += xb * wv.w;
                }
#pragma unroll
                for (int i = 0; i < 4; ++i) {
#pragma unroll
                    for (int m = 8; m <= 32; m <<= 1) { e0[i] += __shfl_xor(e0[i], m, 64); e1[i] += __shfl_xor(e1[i], m, 64); }
                }
                if (lane < 8) {
#pragma unroll
                    for (int i = 0; i < 4; ++i) { lg[4 + 4 * q + i] = e0[i]; lg[36 + 4 + 4 * q + i] = e1[i]; }
                }
                if (j0 + 1 < nrj) { ja.finish(); jb.finish(); }
                if (j0 + 3 < nrj) { ja.issue(p, layer, (j0 + 2) * gstride + gtid); jb.issue(p, layer, (j0 + 3) * gstride + gtid); }
                float g0[4] = {0.f, 0.f, 0.f, 0.f}, g1[4] = {0.f, 0.f, 0.f, 0.f};
#pragma unroll 16
                for (int it = 0; it < 32; ++it) {
                    const float4 wv = *(const float4*)(wg1 + (unsigned)((64 * it + lq) * 4));
                    const float xa = xs[64 * it + lq], xb = xs[2048 + 64 * it + lq];
                    g0[0] += xa * wv.x; g0[1] += xa * wv.y; g0[2] += xa * wv.z; g0[3] += xa * wv.w;
                    g1[0] += xb * wv.x; g1[1] += xb * wv.y; g1[2] += xb * wv.z; g1[3] += xb * wv.w;
                }
#pragma unroll
                for (int i = 0; i < 4; ++i) { g0[i] = wave_sum(g0[i]); g1[i] = wave_sum(g1[i]); }
                if (lane == 0) {
#pragma unroll
                    for (int i = 0; i < 4; ++i) { lg[i] = g0[i]; lg[36 + i] = g1[i]; }
                }
            }
            if (j0 + 3 < nrj) { ja.finish(); jb.finish(); }
            if (lane < 2) {
                const int rr = lane;
                const float* L = lg + 36 * rr;
                float gl[4];
#pragma unroll
                for (int i = 0; i < 4; ++i) gl[i] = L[i] + p.bg1[layer * 4 + i];
                int grp = 0; float gmx = gl[0];
#pragma unroll
                for (int i = 1; i < 4; ++i) if (gl[i] > gmx) { gmx = gl[i]; grp = i; }
                float den = 0.f;
#pragma unroll
                for (int i = 0; i < 4; ++i) den += expf(gl[i] - gmx);
                const float ptop = 1.f / den;
                float v1m = -3.4e38f, v2m = -3.4e38f; int i1 = 0, i2 = 0;
                for (int i = 0; i < 8; ++i) {
                    const float v = L[4 + grp * 8 + i] + p.bg2[layer * 32 + grp * 8 + i];
                    if (v > v1m) { v2m = v1m; i2 = i1; v1m = v; i1 = i; }
                    else if (v > v2m) { v2m = v; i2 = i; }
                }
                const float ex = expf(v2m - v1m);
                const int row = r0 + rr, la = (row - rb) * 2;
                te[la] = (unsigned)(grp * 8 + i1); te[la + 1] = (unsigned)(grp * 8 + i2);
                p.gatev[row * 2] = ptop / (1.f + ex); p.gatev[row * 2 + 1] = ptop * ex / (1.f + ex);
            }
        }
        __syncthreads();
        if (t < 128) lrk[t] = atomicAdd(&lcnt[te[t]], 1u);
        __syncthreads();
        if (t < 32) lcnt[32 + t] = atomicAdd(&p.cnt[layer * 32 + t], lcnt[t]);
        __syncthreads();
        if (t < 128) { const unsigned e = te[t], rk = lcnt[32 + e] + lrk[t]; p.route[rb * 2 + t] = (e << 16) | rk; p.inv[(size_t)e * 32768 + rk] = (unsigned)((rb * 2 + t) >> 1); }
        __syncthreads();
    }
    if (blockIdx.x * 64 >= NTOK) {
        CvtJob ja; const unsigned gtid = blockIdx.x * NTHR + tid_, gstride = gridDim.x * NTHR;
#pragma unroll 1
        for (unsigned j = 0; j < nrj; ++j) { ja.issue(p, layer, j * gstride + gtid); ja.finish(); }
    }
}

DEV const int* moe_tables(const Params& p, char* lds, int layer, int tid_) {
    int* tab = (int*)(lds + LDS_TAB);
    __syncthreads();
    if (tid_ == 0) {
        int up = 0, ro = 0;
        for (int e = 0; e < NEXP; ++e) {
            const int c = (int)p.cnt[layer * 32 + e];
            const int m = (c + 255) >> 8;
            tab[e] = up; tab[40 + e] = m; tab[80 + e] = ro; tab[120 + e] = c;
            up += m * 8; ro += m * 256;
        }
        tab[32] = up;
    }
    __syncthreads();
    return tab;
}
template <bool FINAL>
DEV void phase_combine(const Params& p, char* lds, int layer, const float* xin, float* xout, int tid_) {
    const int lane = tid_ & 63, w = tid_ >> 6;
    const int* tab = moe_tables(p, lds, layer, tid_);
    const u16* Y = (const u16*)p.regA + (size_t)NSLOT * DM;
    int rr = blockIdx.x * NW + w;
    float nga = 0.f, ngb = 0.f; unsigned nr0 = 0u, nr1 = 0u;
    if (rr < NTOK) { nga = p.gatev[rr * 2]; ngb = p.gatev[rr * 2 + 1]; nr0 = p.route[2 * rr]; nr1 = p.route[2 * rr + 1]; }
    for (; rr < NTOK; rr += gridDim.x * NW) {
        const int b = rr / SEQ;
        const float* md = p.mod + ((size_t)layer * 5 + b) * 12288;
        const float ga = nga, gb = ngb;
        const unsigned r0 = nr0, r1 = nr1;
        const u16* ya = Y + (size_t)((unsigned)tab[80 + (r0 >> 16)] + (r0 & 0xffffu)) * DM; const u16* yb = Y + (size_t)((unsigned)tab[80 + (r1 >> 16)] + (r1 & 0xffffu)) * DM;
        float4 v[8]; row_load(xin + (size_t)rr * DM, v, lane);
        u32x2 pa[8], pb[8]; float4 g2[8];
#pragma unroll
        for (int i = 0; i < 8; ++i) { const int c = 4 * lane + 256 * i; pa[i] = *(const u32x2*)(ya + c); pb[i] = *(const u32x2*)(yb + c); g2[i] = *(const float4*)(md + 10240 + c); }
        { const int rn = rr + gridDim.x * NW; if (rn < NTOK) { nga = p.gatev[rn * 2]; ngb = p.gatev[rn * 2 + 1]; nr0 = p.route[2 * rn]; nr1 = p.route[2 * rn + 1]; } }
        __builtin_amdgcn_sched_barrier(0);
#pragma unroll
        for (int i = 0; i < 8; ++i) {
            v[i].x += g2[i].x * (ga * __builtin_bit_cast(float, pa[i].x << 16) + gb * __builtin_bit_cast(float, pb[i].x << 16));
            v[i].y += g2[i].y * (ga * __builtin_bit_cast(float, pa[i].x & 0xffff0000u) + gb * __builtin_bit_cast(float, pb[i].x & 0xffff0000u));
            v[i].z += g2[i].z * (ga * __builtin_bit_cast(float, pa[i].y << 16) + gb * __builtin_bit_cast(float, pb[i].y << 16));
            v[i].w += g2[i].w * (ga * __builtin_bit_cast(float, pa[i].y & 0xffff0000u) + gb * __builtin_bit_cast(float, pb[i].y & 0xffff0000u));
        }
#pragma unroll
        for (int i = 0; i < 8; ++i) *(float4*)(xout + (size_t)rr * DM + 4 * lane + 256 * i) = v[i];
        if (!FINAL) {
            const float* md1 = p.mod + ((size_t)(layer + 1) * 5 + b) * 12288;
            const float rstd = row_rstd(v);
            row_modulate(v, rstd, p.norm1_g + (layer + 1) * DM, md1 + 2048, md1, lane);
            row_store_bf16(p.h + (size_t)rr * DM, v, lane);
        }
    }
}

template <class T> DEV T* uni(T* p) {
    const unsigned long long v = (unsigned long long)p;
    const unsigned lo = __builtin_amdgcn_readfirstlane((unsigned)v), hi = __builtin_amdgcn_readfirstlane((unsigned)(v >> 32));
    typedef T __attribute__((address_space(1))) * GP;
    return (T*)(GP)(((unsigned long long)hi << 32) | lo);
}
template <class T> DEV T ldg(const T* base, unsigned idx) { return *(const T*)((const char*)base + idx * (unsigned)sizeof(T)); }
template <class T> DEV void stg(T* base, unsigned idx, T v) { *(T*)((char*)base + idx * (unsigned)sizeof(T)) = v; }
DEV int tid_opaque(int tl) { int t = tl; asm volatile("" : "+v"(t)); return t; }
DEV float2 cmul(float2 a, float2 b) { return make_float2(a.x * b.x - a.y * b.y, a.x * b.y + a.y * b.x); }
DEV float2 cmulc(float2 a, float2 b) { return make_float2(a.x * b.x + a.y * b.y, a.y * b.x - a.x * b.y); }
DEV int PIX(int i) { return i + (i >> 4); }
constexpr int FA = 4352;
constexpr float cCos16[8] = {1.f, 0.92387953251128674f, 0.70710678118654752f, 0.38268343236508977f, 0.f, -0.38268343236508977f, -0.70710678118654752f, -0.92387953251128674f};
constexpr float cSin16[8] = {0.f, 0.38268343236508977f, 0.70710678118654752f, 0.92387953251128674f, 1.f, 0.92387953251128674f, 0.70710678118654752f, 0.38268343236508977f};
constexpr int brev4(int v) { return ((v & 1) << 3) | ((v & 2) << 1) | ((v & 4) >> 1) | ((v & 8) >> 3); }
template <bool INV> DEV void dft16(float2 (&a)[16]) {
#pragma unroll
    for (int half = 8; half >= 1; half >>= 1) {
#pragma unroll
        for (int blk = 0; blk < 16; blk += 2 * half) {
#pragma unroll
            for (int i = 0; i < half; ++i) {
                const float2 u = a[blk + i], v = a[blk + i + half];
                a[blk + i] = make_float2(u.x + v.x, u.y + v.y);
                const float2 d = make_float2(u.x - v.x, u.y - v.y);
                const int ti = i * (8 / half);
                if (ti == 0) a[blk + i + half] = d;
                else if (ti == 4) a[blk + i + half] = INV ? make_float2(-d.y, d.x) : make_float2(d.y, -d.x);
                else {
                    const float c = cCos16[ti], s = INV ? cSin16[ti] : -cSin16[ti];
                    a[blk + i + half] = make_float2(d.x * c - d.y * s, d.x * s + d.y * c);
                }
            }
        }
    }
    float2 b[16];
#pragma unroll
    for (int k = 0; k < 16; ++k) b[k] = a[brev4(k)];
#pragma unroll
    for (int k = 0; k < 16; ++k) a[k] = b[k];
}
template <bool CONJ> DEV void apply_pows16(float2 (&a)[16], float2 w1) {
    float2 B[4]; B[0] = make_float2(1.f, 0.f); B[1] = w1; B[2] = cmul(w1, w1); B[3] = cmul(B[2], w1);
    const float2 w4 = cmul(B[2], B[2]);
    float2 A = make_float2(1.f, 0.f);
#pragma unroll
    for (int q = 0; q < 4; ++q) {
#pragma unroll
        for (int b = 0; b < 4; ++b) {
            if (q == 0 && b == 0) continue;
            const float2 wk = (q == 0) ? B[b] : (b == 0 ? A : cmul(A, B[b]));
            a[q * 4 + b] = CONJ ? cmulc(a[q * 4 + b], wk) : cmul(a[q * 4 + b], wk);
        }
        A = cmul(A, w4);
    }
}
DEV void twA_load(float2 (&w)[16], const float2* twA, int tl) {
    const int t = tid_opaque(tl);
#pragma unroll
    for (int k = 1; k < 16; ++k) w[k] = ldg(twA, (unsigned)(k * 256 + t));
}
DEV void fA_fwd(float2* X, const float2 (&w)[16], float2 (&a)[16], int tl) {
    const int t = tid_opaque(tl);
    dft16<false>(a);
#pragma unroll
    for (int k = 1; k < 16; ++k) a[k] = cmul(a[k], w[k]);
    float2* Xb = X + (t + (t >> 4));
#pragma unroll
    for (int k = 0; k < 16; ++k) Xb[272 * k] = a[k];
}
DEV void fA_inv_read(const float2* X, float2 (&a)[16], int tl) {
    const int t = tid_opaque(tl);
    const float2* Xb = X + (t + (t >> 4));
#pragma unroll
    for (int k = 0; k < 16; ++k) a[k] = Xb[272 * k];
}
DEV void fA_inv_math(const float2 (&w)[16], float2 (&a)[16]) {
#pragma unroll
    for (int k = 1; k < 16; ++k) a[k] = cmulc(a[k], w[k]);
    dft16<true>(a);
}
template <bool INV> DEV void fB2(float2* X, const float2* tw  , int tl) {
    const int id = tid_opaque(tl), k = id >> 4, j2 = id & 15;
    float2 a[16], b[16], w[16];
    float2* Xa = X + PIX(256 * k + j2);
    float2* Xb = Xa + FA;
#pragma unroll
    for (int m = 1; m < 16; ++m) w[m] = tw[m * 16 + j2];
#pragma unroll
    for (int m = 0; m < 16; ++m) { a[m] = Xa[17 * m]; b[m] = Xb[17 * m]; }
    __builtin_amdgcn_sched_barrier(0);
    if (!INV) {
        dft16<false>(a); dft16<false>(b);
#pragma unroll
        for (int m = 1; m < 16; ++m) { a[m] = cmul(a[m], w[m]); b[m] = cmul(b[m], w[m]); }
    } else {
#pragma unroll
        for (int m = 1; m < 16; ++m) { a[m] = cmulc(a[m], w[m]); b[m] = cmulc(b[m], w[m]); }
        dft16<true>(a); dft16<true>(b);
    }
#pragma unroll
    for (int m = 0; m < 16; ++m) { Xa[17 * m] = a[m]; Xb[17 * m] = b[m]; }
}
DEV void fC2_store(const float2* X, float2* ksp, float scale, int tl) {
    const int t = tid_opaque(tl);
    const float2* Xa = X + 17 * t;
    float2 a[16], b[16];
#pragma unroll
    for (int m = 0; m < 16; ++m) { a[m] = Xa[m]; b[m] = Xa[FA + m]; }
    dft16<false>(a); dft16<false>(b);
#pragma unroll
    for (int m = 0; m < 16; ++m) { stg(ksp, (unsigned)(m * 256 + t), make_float2(a[m].x * scale, a[m].y * scale)); stg(ksp, (unsigned)(4096 + m * 256 + t), make_float2(b[m].x * scale, b[m].y * scale)); }
}
DEV void fC2_mul(float2* X, const float2* ksp, int tl) {
    const int t = tid_opaque(tl);
    float2* Xa = X + 17 * t;
    float2 a[16], b[16];
#pragma unroll
    for (int m = 0; m < 16; ++m) { a[m] = Xa[m]; b[m] = Xa[FA + m]; }
    dft16<false>(a); dft16<false>(b);
#pragma unroll
    for (int m = 0; m < 16; ++m) { a[m] = cmul(a[m], ldg(ksp, (unsigned)(m * 256 + t))); b[m] = cmul(b[m], ldg(ksp, (unsigned)(4096 + m * 256 + t))); }
    dft16<true>(a); dft16<true>(b);
#pragma unroll
    for (int m = 0; m < 16; ++m) { Xa[m] = a[m]; Xa[FA + m] = b[m]; }
}
template <bool MUL> DEV void sconv_fill(float2 (&a)[16], const u16* row  , int zrow, int b0, const float* cw, const float* cb_, int tl) {
    const int t = tid_opaque(tl);
    float w0 = cw[zrow], w1 = cw[6144 + zrow], w2 = cw[12288 + zrow], cb = cb_[zrow];
    const unsigned i0 = (unsigned)(zrow * NTOK + b0 * SEQ + t);
#pragma unroll
    for (int m = 0; m < 16; ++m) {
        const unsigned i = i0 + 256u * m;
        float l0, l1, r0, r1;
        if (m == 0)  { const unsigned o = t > 0 ? 1u : 0u; const float k = t > 0 ? 1.f : 0.f; l0 = k * bf2f(ldg(row, i - o)); l1 = k * bf2f(ldg(row, i + SEQ - o)); }
        else         { l0 = bf2f(ldg(row, i - 1)); l1 = bf2f(ldg(row, i + SEQ - 1)); }
        if (m == 15) { const unsigned o = t < 255 ? 1u : 0u; const float k = t < 255 ? 1.f : 0.f; r0 = k * bf2f(ldg(row, i + o)); r1 = k * bf2f(ldg(row, i + SEQ + o)); }
        else         { r0 = bf2f(ldg(row, i + 1)); r1 = bf2f(ldg(row, i + SEQ + 1)); }
        const float v0 = cb + w0 * l0 + w1 * bf2f(ldg(row, i)) + w2 * r0;
        const float v1 = cb + w0 * l1 + w1 * bf2f(ldg(row, i + SEQ)) + w2 * r1;
        if (MUL) { a[m].x *= v0; a[m].y *= v1; } else a[m] = make_float2(v0, v1);
        if ((m & 3) == 3) __builtin_amdgcn_sched_barrier(0);
    }
}
template <class F> DEV void conv_fwdA(float2* X, const float2* tw, const float2* twA, const float2 (&z)[16], int tl, F&& side_issue) {
    float2 a[16], b[16], w[16];
    const int t = tid_opaque(tl);
    twA_load(w, twA, tl);
#pragma unroll
    for (int m = 0; m < 16; ++m) b[m] = ldg(tw, (unsigned)(t + 256 * m));
    __builtin_amdgcn_sched_barrier(0);
    side_issue();
    __builtin_amdgcn_sched_barrier(0);
#pragma unroll
    for (int m = 0; m < 16; ++m) a[m] = z[m];
    fA_fwd(X, w, a, tl);
#pragma unroll
    for (int m = 0; m < 16; ++m) a[m] = cmul(z[m], b[m]);
    fA_fwd(X + FA, w, a, tl);
}
DEV void conv_invA(const float2* X, const float2* tw, const float2* twA, float2 (&z)[16], int tl) {
    float2 o[16], w[16], wa[16];
    const int t = tid_opaque(tl);
    twA_load(wa, twA, tl);
#pragma unroll
    for (int m = 0; m < 16; ++m) w[m] = ldg(tw, (unsigned)(t + 256 * m));
    fA_inv_read(X, z, tl); fA_inv_read(X + FA, o, tl);
    __builtin_amdgcn_sched_barrier(0);
    fA_inv_math(wa, z);
    fA_inv_math(wa, o);
#pragma unroll
    for (int m = 0; m < 16; ++m) { const float2 r = cmulc(o[m], w[m]); z[m].x += r.x; z[m].y += r.y; }
}
DEV void phase_hy_conv(const Params& p, char* lds, int tid_) {
    const int sub = __builtin_amdgcn_readfirstlane(tid_ >> 8), tl = tid_ & 255;
    float2* X = (float2*)(lds + sub * 69632);
    const u16* zT = uni(p.regB);
    float2* ksp = uni(p.ksp + (size_t)(blockIdx.x * 2 + sub) * 2 * 8192);
    const float2* tw = uni(p.tw); const float2* twA = tw + 8192;
    float2* twB = (float2*)(lds + LDS_TAB);
    if (tid_ < 256) twB[tid_] = tw[12288 + tid_];
    __syncthreads();
    const unsigned gtid = blockIdx.x * NTHR + tid_, gstride = gridDim.x * NTHR, njobs = (NEXP * 3u * 65536u + gstride - 1u) / gstride;
    unsigned jn = 0u;
    CvtJob cj;
#define CJ_ISSUE() do { if (jn < njobs) cj.issue(p, 1, jn * gstride + gtid); } while (0)
#define CJ_FINISH() do { if (jn < njobs) { cj.finish(); ++jn; } } while (0)
#pragma unroll 1
    for (int c = blockIdx.x * 2 + sub; c < DM; c += gridDim.x * 2) {
        const float dl = fabsf(-3.0701134573253946f + (-15.350567286626973f + 3.0701134573253946f) * (float)c / 2047.f) * (1.f / (float)(SEQ - 1));
#pragma unroll 1
        for (int o = 0; o < 2; ++o) {
            const unsigned hfo = (unsigned)((o * 4096 + c) * SEQ), hbo = (unsigned)((o * 4096 + 2048 + c) * SEQ);
            const float bias = p.hy_bias[o * DM + c];
            CJ_ISSUE();
            __syncthreads();
            {
                const int t = tid_opaque(tl);
                u16 lv[16], hv[16];
#pragma unroll
                for (int m = 0; m < 16; ++m) {
                    const int n = t + 256 * m;
                    const int nb = n == 0 ? 1 : SEQ - n;
                    lv[m] = ((const u16*)p.filtT)[hfo + (unsigned)n]; hv[m] = ((const u16*)p.filtT)[hbo + (unsigned)nb];
                }
                float sm[16], df[16];
#pragma unroll
                for (int m = 0; m < 16; ++m) {
                    const int n = t + 256 * m;
                    const int nb = n == 0 ? 1 : SEQ - n;
                    const float lo = bf2f(lv[m]) * __expf(-(float)n * dl) + (n == 0 ? bias : 0.f);
                    const float hi = (n == 0 ? 0.f : 1.f) * (bf2f(hv[m]) * __expf(-(float)nb * dl));
                    sm[m] = lo + hi; df[m] = lo - hi;
                }
                float2 a[16], wa[16];
                twA_load(wa, twA, tl);
#pragma unroll
                for (int m = 0; m < 16; ++m) a[m] = make_float2(sm[m], 0.f);
                fA_fwd(X, wa, a, tl);
#pragma unroll
                for (int m = 0; m < 16; ++m) { const float2 w = ldg(tw, (unsigned)(t + 256 * m)); a[m] = make_float2(df[m] * w.x, df[m] * w.y); }
                fA_fwd(X + FA, wa, a, tl);
            }
            __syncthreads();
            CJ_FINISH(); CJ_ISSUE();
            fB2<false>(X, twB, tl);
            asm volatile("s_waitcnt lgkmcnt(0)" ::: "memory"); __builtin_amdgcn_wave_barrier(); __builtin_amdgcn_sched_barrier(0);
            fC2_store(X, ksp + o * 8192, 1.f / 8192.f, tl);
            CJ_FINISH();
        }
#pragma unroll 1
        for (int pr = 0; pr < 2; ++pr) {
            const int b0 = 2 * pr;
            float2 z[16];
            sconv_fill<false>(z, zT, c, b0, p.hy_conv_w, p.hy_conv_b, tl);
            __syncthreads();
#pragma unroll 1
            for (int o = 0; o < 2; ++o) {
                conv_fwdA(X, tw, twA, z, tl, [&]() { CJ_ISSUE(); });
                __syncthreads();
                CJ_FINISH(); CJ_ISSUE();
                fB2<false>(X, twB, tl);
                asm volatile("s_waitcnt lgkmcnt(0)" ::: "memory"); __builtin_amdgcn_wave_barrier(); __builtin_amdgcn_sched_barrier(0);
                fC2_mul(X, ksp + o * 8192, tl);
                asm volatile("s_waitcnt lgkmcnt(0)" ::: "memory"); __builtin_amdgcn_wave_barrier(); __builtin_amdgcn_sched_barrier(0);
                fB2<true>(X, twB, tl);
                __syncthreads();
                CJ_FINISH();
                conv_invA(X, tw, twA, z, tl);
                sconv_fill<true>(z, zT, (o + 1) * 2048 + c, b0, p.hy_conv_w, p.hy_conv_b, tl);
            }
            const int t = tid_opaque(tl);
            u16* y2T = (u16*)p.regC;
#pragma unroll
            for (int m = 0; m < 16; ++m) { y2T[(unsigned)(c * NTOK + b0 * SEQ + t + 256 * m)] = f2bf(z[m].x); y2T[(unsigned)(c * NTOK + b0 * SEQ + SEQ + t + 256 * m)] = f2bf(z[m].y); }
        }
        __syncthreads();
    }
#pragma unroll 1
    while (jn < njobs) { CJ_ISSUE(); CJ_FINISH(); }
#undef CJ_ISSUE
#undef CJ_FINISH
}
DEV void phase_transpose_y2(const Params& p, char* lds, int tid_) {
    const u16* src = (const u16*)p.regC; u16* dst = (u16*)p.regC + (size_t)DM * NTOK;
    u16* tl = (u16*)lds;
    const int t = tid_;
    auto tload = [&](int j) -> u32x4 { const int ct = j & 31, tt = j >> 5, r = t >> 3, ch = (t & 7) * 8; return *(const u32x4*)(src + (size_t)(ct * 64 + r) * NTOK + tt * 64 + ch); };
    u32x4 nxt = tload(blockIdx.x);
    for (int j = blockIdx.x; j < 32 * 256; j += gridDim.x) {
        const int ct = j & 31, tt = j >> 5;
        { const int r = t >> 3, ch = (t & 7) * 8;
          *(u32x4*)(tl + r * 72 + ch) = nxt; }
        if (j + (int)gridDim.x < 32 * 256) nxt = tload(j + gridDim.x);
        __syncthreads();
        { const int r = t >> 3, ch = (t & 7) * 8;
          u16 v[8];
#pragma unroll
          for (int k = 0; k < 8; ++k) v[k] = tl[(ch + k) * 72 + r];
          u32x4 o; o.x = v[0] | ((unsigned)v[1] << 16); o.y = v[2] | ((unsigned)v[3] << 16); o.z = v[4] | ((unsigned)v[5] << 16); o.w = v[6] | ((unsigned)v[7] << 16);
          *(u32x4*)(dst + (size_t)(tt * 64 + r) * DM + ct * 64 + ch) = o; }
        __syncthreads();
    }
}

__global__ void __launch_bounds__(NTHR, 2) mega(Params p_) {
    extern __shared__ __attribute__((aligned(16))) char lds[];
    LAS unsigned char* ldsl = (LAS unsigned char*)lds;
    uint4* xbw = (uint4*)(lds + LDS_BYTES - 16);
    const int widx_ = __builtin_amdgcn_readfirstlane(threadIdx.x >> 6);
    const int ph_lo = p_.ph_lo, ph_hi = p_.ph_hi;
    const bool multi = (ph_hi - ph_lo) > 1;
    XcdBarrier bar;
    bar.bar = p_.bar; bar.x = 0; bar.st = (volatile LAS unsigned*)xbw;
    if (multi) {
        if (threadIdx.x == 0) *xbw = make_uint4(0u, 0u, 0u, 0u);
        __syncthreads();
        bar = xcd_barrier_post(p_.bar, (volatile LAS unsigned*)xbw);
    }
#ifndef ONLY_PHASE
#define ONLY_PHASE -1
#endif
#define PH(n, ...) if ((ONLY_PHASE < 0 || ONLY_PHASE == (n)) && ph_lo <= (n) && (n) < ph_hi) { \
        const __attribute__((address_space(4))) char* kp_ = (const __attribute__((address_space(4))) char*)__builtin_amdgcn_kernarg_segment_ptr(); asm volatile("" : "+s"(kp_)); \
        const Params& p = *(const Params*)kp_; const int tid_ = widx_ * 64 + (int)__builtin_amdgcn_mbcnt_hi(~0u, __builtin_amdgcn_mbcnt_lo(~0u, 0u)); __VA_ARGS__; if ((n) + 1 < ph_hi) xcd_barrier(bar, tid_); }
    PH(0,  phase_prologue(p, lds, tid_))
    PH(1,  { phase_norm1_l0(p, tid_); pg8::StaticOrder S; S.init(p.wt_w3, p.a2p, 8192, SEQ, 256); EpiBf16Store E{(u16*)p.filtT, SEQ, nullptr}; pg8::gemm_phase<false>(ldsl, 256, S, E, tid_); })
    PH(2,  { pg8::StaticOrder S; S.init(p.h, p.wt_attn_in, NROW, AIN, DM); EpiQKNorm E{p.regB, p.gains, (float*)(lds + 131072), (char*)p.regA}; pg8::gemm_phase<false>(ldsl, DM, S, E, tid_); })
    PH(4,  phase_attention(p, lds, tid_))
    PH(6,  { pg8::StaticOrder S; S.init(p.attn_out, p.wt_attn_out, NTOK, DM, DM); EpiResid E{p.x, p.x1, p.mod + 4096, nullptr}; pg8::gemm_phase<false>(ldsl, DM, S, E, tid_); })
    PH(7,  phase_norm2_route(p, lds, 0, p.x1, tid_))
    PH(9,  { const int* tab = moe_tables(p, lds, 0, tid_); pg8::MoeOrder S; S.init(p.h2, DM, p.wt_gu, (size_t)2048 * 2048, tab, p.inv); EpiMoe1 E{p.act}; pg8::gemm_phase<true>(ldsl, DM, S, E, tid_); })
    PH(10, { const int* tab = moe_tables(p, lds, 0, tid_); pg8::MoeOrder S; S.init(p.act, FF, p.wt_dn, (size_t)2048 * 1024, tab, nullptr); EpiBf16Store E{(u16*)p.regA + (size_t)NSLOT * DM, DM, nullptr}; pg8::gemm_phase<false>(ldsl, FF, S, E, tid_); })
    PH(11, phase_combine<false>(p, lds, 0, p.x1, p.x2, tid_))
    PH(12, { pg8::StaticOrder S; S.init(p.wt_hy_in, p.h, 6144, NTOK, DM); EpiBf16Store E{p.regB, NTOK, p.hy_b_in}; pg8::gemm_phase<false>(ldsl, DM, S, E, tid_); })
    PH(13, phase_hy_conv(p, lds, tid_))
    PH(14, phase_transpose_y2(p, lds, tid_))
    PH(15, { pg8::StaticOrder S; S.init((u16*)p.regC + (size_t)DM * NTOK, p.wt_hy_out, NTOK, DM, DM); EpiResid E{p.x2, p.x1, p.mod + (size_t)5 * 12288 + 4096, p.hy_b_out}; pg8::gemm_phase<false>(ldsl, DM, S, E, tid_); })
    PH(16, phase_norm2_route(p, lds, 1, p.x1, tid_))
    PH(18, { const int* tab = moe_tables(p, lds, 1, tid_); pg8::MoeOrder S; S.init(p.h2, DM, p.wt_gu, (size_t)2048 * 2048, tab, p.inv); EpiMoe1 E{p.act}; pg8::gemm_phase<true>(ldsl, DM, S, E, tid_); })
    PH(19, { const int* tab = moe_tables(p, lds, 1, tid_); pg8::MoeOrder S; S.init(p.act, FF, p.wt_dn, (size_t)2048 * 1024, tab, nullptr); EpiBf16Store E{(u16*)p.regA + (size_t)NSLOT * DM, DM, nullptr}; pg8::gemm_phase<false>(ldsl, FF, S, E, tid_); })
    PH(20, (phase_combine<true>(p, lds, 1, p.x1, p.out, tid_)))
}

extern "C" void kernel_launch(void* const* d_in, const int* in_sizes, int n_in, void* d_out, int out_size, void* d_ws, size_t ws_size, hipStream_t stream) {
    static int grid = 0;
    if (!grid) {
        int dev = 0, cus = 0, per_cu = 0;
        (void)hipGetDevice(&dev);
        (void)hipDeviceGetAttribute(&cus, hipDeviceAttributeMultiprocessorCount, dev);
        (void)hipFuncSetAttribute((const void*)mega, hipFuncAttributeMaxDynamicSharedMemorySize, LDS_BYTES);
        (void)hipOccupancyMaxActiveBlocksPerMultiprocessor(&per_cu, mega, NTHR, LDS_BYTES);
        if (per_cu > 1) per_cu = 1;
        if (per_cu < 1) per_cu = 1;
        grid = cus * per_cu;
    }
    Params p; memset(&p, 0, sizeof(p));
    const float* const* in = (const float* const*)d_in;
    p.x = in[0]; p.c = in[1]; p.ctx = in[2]; p.c_ctx = in[3]; p.ada_w = in[4]; p.ada_b = in[5]; p.norm1_g = in[6]; p.norm2_g = in[7];
    p.attn_w_in = in[8]; p.attn_w_out = in[9]; p.diff_q_g = in[10]; p.diff_k_g = in[11]; p.lq1 = in[12]; p.lk1 = in[13]; p.lq2 = in[14]; p.lk2 = in[15];
    p.diff_sub_g = in[16]; p.swa_q_g = in[17]; p.swa_k_g = in[18]; p.swa_sink = in[19];
    p.hy_w_in = in[20]; p.hy_b_in = in[21]; p.hy_conv_w = in[22]; p.hy_conv_b = in[23];
    p.flt_w1 = in[24]; p.flt_b1 = in[25]; p.flt_f1 = in[26]; p.flt_w2 = in[27]; p.flt_b2 = in[28]; p.flt_f2 = in[29]; p.flt_w3 = in[30];
    p.hy_bias = in[31]; p.hy_w_out = in[32]; p.hy_b_out = in[33];
    p.wg1 = in[34]; p.bg1 = in[35]; p.wg2 = in[36]; p.bg2 = in[37]; p.w_gate = in[38]; p.w_up = in[39]; p.w_down = in[40];
    p.out = (float*)d_out;
    char* ws = (char*)d_ws; size_t off = 0;
    auto take = [&](size_t bytes) { char* r = ws + off; off += (bytes + 255) & ~(size_t)255; return r; };
    p.bar = (unsigned*)take(XCD_BAR_WORDS * 4);
    p.mod = (float*)take((size_t)2 * 5 * 12288 * 4);
    p.tw = (float2*)take((8192 + 4096 + 256) * 8);
    p.a2p = (u16*)take((size_t)4096 * 256 * 2);
    p.gains = (float*)take(512 * 4);
    p.cnt = (unsigned*)take(64 * 4);
    p.route = (unsigned*)take((size_t)32768 * 4);
    p.inv = (unsigned*)take((size_t)NEXP * 32768 * 4);
    p.gatev = (float*)take((size_t)32768 * 4);
    p.wt_attn_in = (u16*)take((size_t)AIN * DM * 2);
    p.wt_attn_out = (u16*)take((size_t)DM * DM * 2);
    p.wt_hy_in = (u16*)take((size_t)6144 * DM * 2);
    p.wt_hy_out = (u16*)take((size_t)DM * DM * 2);
    p.wt_w3 = (u16*)take((size_t)8192 * 256 * 2);
    p.wt_gu = (u16*)take((size_t)NEXP * 2048 * 2048 * 2);
    p.wt_dn = (u16*)take((size_t)NEXP * 2048 * 1024 * 2);
    p.h = (u16*)take((size_t)NROW * DM * 2);
    p.regA = (float*)take((size_t)NSLOT * DM * 2 * 2);
    p.regB = (u16*)take((size_t)6144 * NTOK * 2);
    p.regC = (float*)take((size_t)NTOK * DM * 4);
    p.attn_out = (u16*)take((size_t)NTOK * DM * 2);
    p.x1 = (float*)take((size_t)NTOK * DM * 4);
    p.x2 = (float*)take((size_t)NTOK * DM * 4);
    p.h2 = (u16*)take((size_t)NTOK * DM * 2);
    p.act = (u16*)take((size_t)NSLOT * FF * 2);
    p.filtT = (float*)take((size_t)8192 * SEQ * 4);
    p.ksp = (float2*)take((size_t)grid * 2 * 2 * 8192 * 8);
#ifndef HOST_DUP_MASK
#define HOST_DUP_MASK 0
#endif
#if N_LAUNCH_SPLIT
    for (int ph = 0; ph < NPHASE; ++ph) {
        p.ph_lo = ph; p.ph_hi = ph + 1;
        for (int rep = 0; rep <= ((HOST_DUP_MASK >> ph) & 1); ++rep)
            hipLaunchKernelGGL(mega, dim3(grid), dim3(NTHR), LDS_BYTES, stream, p);
    }
#else
    (void)hipMemsetAsync(p.bar, 0, XCD_BAR_WORDS * 4, stream);
    p.ph_lo = 0; p.ph_hi = NPHASE;
    hipLaunchKernelGGL(mega, dim3(grid), dim3(NTHR), LDS_BYTES, stream, p);
#endif
}
```

```cpp
#include <hip/hip_runtime.h>
#include <stdint.h>
#include <string.h>

#ifndef N_LAUNCH_SPLIT
#define N_LAUNCH_SPLIT 0
#endif

typedef unsigned short u16;
typedef __attribute__((ext_vector_type(8))) short bf16x8;
typedef __attribute__((ext_vector_type(4))) float f32x4;
typedef __attribute__((ext_vector_type(16))) float f32x16;
typedef __attribute__((ext_vector_type(4))) unsigned u32x4;
typedef __attribute__((ext_vector_type(2))) unsigned u32x2;
#define DEV __device__ __forceinline__
#define LAS __attribute__((address_space(3)))

constexpr int DM = 2048, NB = 4, SEQ = 4096, NTOK = NB * SEQ, CTXL = 256;
constexpr int RB = CTXL + SEQ;
constexpr int NROW = NB * RB;
constexpr int AIN = 4608;
constexpr int NEXP = 32, FF = 1024, NSLOT = 40960;
constexpr float EPSN = 1e-6f;
constexpr float LOG2E = 1.4426950408889634f;
constexpr int NTHR = 512, NW = 8;
constexpr int LDS_BYTES = 147456;
constexpr int LDS_TAB = 139264;
constexpr int NPHASE = 21;
constexpr int NTILE = NROW / 64;
constexpr size_t IMG_KD = 0, IMG_VD = IMG_KD + (size_t)16 * NTILE * 8192, IMG_KS = IMG_VD + (size_t)8 * NTILE * 16384, IMG_VS = IMG_KS + (size_t)2 * NTILE * 16384;

#define XB_TMO      128
#define XB_XCNT(j)  (256  + 64 * (j))
#define XB_XSUB(j)  (1280 + 64 * (j))
#define XB_XGEN(j)  (2304 + 64 * (j))
#define XB_TOP      3328
#define XB_TOPGEN   3392
#define XCD_BAR_WORDS 3456
#define XB_SPIN_CAP (1u << 22)
DEV unsigned xb_ld(unsigned* p)              { return __hip_atomic_load(p, __ATOMIC_RELAXED, __HIP_MEMORY_SCOPE_AGENT); }
DEV unsigned xb_add(unsigned* p, unsigned v) { return __hip_atomic_fetch_add(p, v, __ATOMIC_RELAXED, __HIP_MEMORY_SCOPE_AGENT); }
DEV unsigned xb_xcc_id() { return (unsigned)__builtin_amdgcn_s_getreg((3 << 11) | 20) & 0xFu; }
#define XB_SPIN(cond, bar) do { unsigned _sp = 0; while (cond) { __builtin_amdgcn_s_sleep(1); \
    if ((++_sp & 255u) == 0u) { if (xb_ld(&(bar)[XB_TMO])) break; if (_sp > XB_SPIN_CAP) { atomicAdd(&(bar)[XB_TMO], 1u); break; } } } } while (0)
struct XcdBarrier { unsigned* bar; unsigned x; volatile LAS unsigned* st; };
DEV XcdBarrier xcd_barrier_post(unsigned* bar, volatile LAS unsigned* st) {
    XcdBarrier b; b.bar = bar; b.x = xb_xcc_id(); b.st = st;
    if (threadIdx.x == 0) (void)xb_add(&bar[XB_XCNT(b.x)], 1u);
    return b;
}
DEV void xcd_barrier_complete(unsigned* bar, unsigned x, unsigned& nloc, unsigned& nx) {
    const unsigned G = gridDim.x * gridDim.y * gridDim.z;
    unsigned sum, cnt, mine, sp = 0u;
    for (;;) {
        sum = 0u; cnt = 0u; mine = 0u;
#pragma unroll
        for (unsigned j = 0; j < 16; ++j) { const unsigned c = xb_ld(&bar[XB_XCNT(j)]); sum += c; cnt += (c > 0u) ? 1u : 0u; mine = (j == x) ? c : mine; }
        if (sum == G) break;
        __builtin_amdgcn_s_sleep(1);
        if ((++sp & 255u) == 0u) { if (xb_ld(&bar[XB_TMO])) break; if (sp > XB_SPIN_CAP) { atomicAdd(&bar[XB_TMO], 1u); break; } }
    }
    nloc = mine > 0u ? mine : 1u; nx = cnt > 0u ? cnt : 1u;
}
DEV void xcd_barrier(const XcdBarrier& b, int tid_) {
    asm volatile("s_waitcnt vmcnt(0)" ::: "memory");
    __syncthreads();
    if (tid_ == 0) {
        unsigned* bar = b.bar;
        __builtin_amdgcn_s_waitcnt(0);
        unsigned nloc = b.st[0], nx = b.st[1];
        if (nloc == 0u) { xcd_barrier_complete(bar, b.x, nloc, nx); b.st[0] = nloc; b.st[1] = nx; }
        const unsigned old = xb_add(&bar[XB_XSUB(b.x)], 1u);
        const unsigned gen = old / nloc;
        if (old + 1u == (gen + 1u) * nloc) {
            __builtin_amdgcn_fence(__ATOMIC_RELEASE, "agent");
            asm volatile("s_waitcnt vmcnt(0)" ::: "memory");
            const unsigned og = xb_add(&bar[XB_TOP], 1u);
            const unsigned tg = og / nx;
            if (og + 1u == (tg + 1u) * nx) xb_add(&bar[XB_TOPGEN], 1u);
            else XB_SPIN(xb_ld(&bar[XB_TOPGEN]) == tg, bar);
            __builtin_amdgcn_fence(__ATOMIC_ACQUIRE, "agent");
            xb_add(&bar[XB_XGEN(b.x)], 1u);
            asm volatile("s_waitcnt vmcnt(0)" ::: "memory");
        } else {
            XB_SPIN(xb_ld(&bar[XB_XGEN(b.x)]) == gen, bar);
            __builtin_amdgcn_fence(__ATOMIC_ACQUIRE, "agent");
            asm volatile("s_waitcnt vmcnt(0)" ::: "memory");
        }
    }
    __syncthreads();
}

struct Params {
    const float *x, *c, *ctx, *c_ctx, *ada_w, *ada_b, *norm1_g, *norm2_g, *attn_w_in, *attn_w_out;
    const float *diff_q_g, *diff_k_g, *lq1, *lk1, *lq2, *lk2, *diff_sub_g, *swa_q_g, *swa_k_g, *swa_sink;
    const float *hy_w_in, *hy_b_in, *hy_conv_w, *hy_conv_b, *flt_w1, *flt_b1, *flt_f1, *flt_w2, *flt_b2, *flt_f2, *flt_w3;
    const float *hy_bias, *hy_w_out, *hy_b_out, *wg1, *bg1, *wg2, *bg2, *w_gate, *w_up, *w_down;
    float* out;
    unsigned* bar;
    float* mod;
    float2* tw;
    u16* a2p;
    float* gains;
    unsigned* cnt;
    unsigned* route;
    unsigned* inv;
    float* gatev;
    u16 *wt_attn_in, *wt_attn_out, *wt_hy_in, *wt_hy_out, *wt_w3;
    u16 *wt_gu, *wt_dn;
    u16* h;
    float* regA;
    u16* regB;
    float* regC;
    u16* attn_out;
    float* x1;
    float* x2;
    u16* h2;
    u16* act;
    float* filtT;
    float2* ksp;
    int ph_lo, ph_hi;
};

typedef __bf16 bf16x2_t __attribute__((ext_vector_type(2)));
typedef float f32x2_t __attribute__((ext_vector_type(2)));
DEV unsigned cvt_pk_bf16n(float lo, float hi) { f32x2_t v = {lo, hi}; return __builtin_bit_cast(unsigned, __builtin_convertvector(v, bf16x2_t)); }
DEV unsigned cvt_pk_bf16(float lo, float hi) { unsigned r; asm volatile("v_cvt_pk_bf16_f32 %0, %1, %2" : "=v"(r) : "v"(lo), "v"(hi)); return r; }
DEV float bf2f(u16 v) { return __builtin_bit_cast(float, (unsigned)v << 16); }
DEV u16 f2bf(float f) { return (u16)(cvt_pk_bf16(f, 0.f) & 0xffffu); }
DEV float wave_sum(float v) {
#pragma unroll
    for (int m = 32; m >= 1; m >>= 1) v += __shfl_xor(v, m, 64);
    return v;
}
DEV float wave_max(float v) {
#pragma unroll
    for (int m = 32; m >= 1; m >>= 1) v = fmaxf(v, __shfl_xor(v, m, 64));
    return v;
}
DEV float silu(float v) { return v / (1.f + __expf(-v)); }
DEV f32x16 mfma32(bf16x8 a, bf16x8 b, f32x16 c) { return __builtin_amdgcn_mfma_f32_32x32x16_bf16(a, b, c, 0, 0, 0); }

namespace pg8 {
constexpr int BM = 256, BK = 64, HALF = 128, HTB = HALF * BK * 2, STAGE_BYTES = 8 * HTB, NXCD = 8, WGM = 8;
DEV int lds_byte(int r, int c) { const int st = (r >> 4) * 2 + (c >> 5), rr = r & 15, cc = c & 31, ob = rr * 64 + cc * 2; return st * 1024 + (ob ^ (((ob >> 9) & 1) << 5)); }
DEV void stage_rc(int b, int& R, int& C) { const int st = b / 1024, sb = b % 1024, swz = sb ^ (((sb >> 9) & 1) << 5); R = (st >> 1) * 16 + swz / 64; C = (st & 1) * 32 + (swz % 64) / 2; }
struct Unit { int row0, col0; const char* a; const char* b; const unsigned* gl; int gcnt; };
DEV int xcd_remap(int wgid, int nwg) { const int q = nwg / NXCD, r = nwg % NXCD, xcd = wgid % NXCD, off = wgid / NXCD; return (xcd < r ? xcd * (q + 1) : r * (q + 1) + (xcd - r) * q) + off; }
struct StaticOrder {
    const char* A; const char* Bt; size_t tstep; int nM, nN, nwg, G, c;
    DEV void init(const void* A_, const void* Bt_, int M, int N, int K) { A = (const char*)A_; Bt = (const char*)Bt_; tstep = (size_t)BM * K * 2; nM = M / BM; nN = N / BM; nwg = nM * nN; G = gridDim.x; c = blockIdx.x; }
    DEV bool next(int i, Unit& u) const {
        const long L = (long)i * G + c; if (L >= nwg) return false;
        const int wgid = xcd_remap((int)L, nwg);
        const int nig = WGM * nN, gid = wgid / nig, fm = gid * WGM, gsz = (nM - fm) < WGM ? (nM - fm) : WGM;
        const int pm = fm + ((wgid % nig) % gsz), pn = (wgid % nig) / gsz;
        u.row0 = pm * BM; u.col0 = pn * BM; u.a = A + (size_t)pm * tstep; u.b = Bt + (size_t)pn * tstep; u.gl = nullptr; u.gcnt = 0; return true;
    }
};
struct MoeOrder {
    const char* A; const char* W; size_t a_rowbytes, w_expert_bytes, w_tstep; const int* tab; int nwg, G, c; const unsigned* inv;
    DEV void init(const void* A_, int Ka, const void* W_, size_t wexp_elems, const int* tab_, const unsigned* inv_) {
        inv = inv_; A = (const char*)A_; a_rowbytes = (size_t)Ka * 2; W = (const char*)W_; w_expert_bytes = wexp_elems * 2; w_tstep = (size_t)BM * Ka * 2; tab = tab_; nwg = tab_[32]; G = gridDim.x; c = blockIdx.x; }
    DEV bool next(int i, Unit& u) const {
        const long L = (long)i * G + c; if (L >= nwg) return false;
        const int w = xcd_remap((int)L, nwg);
        int e = 0;
#pragma unroll 1
        for (int j = 1; j < NEXP; ++j) if (tab[j] <= w) e = j;
        const int rem = w - tab[e], mt = tab[40 + e], pn = rem / mt, pml = rem - pn * mt;
        u.row0 = tab[80 + e] + pml * BM; u.col0 = pn * BM;
        u.b = W + (size_t)e * w_expert_bytes + (size_t)pn * w_tstep;
        if (inv) { u.a = A; u.gl = inv + (size_t)e * 32768 + pml * BM; u.gcnt = tab[120 + e] - pml * BM; }
        else     { u.a = A + (size_t)u.row0 * a_rowbytes; u.gl = nullptr; u.gcnt = 0; }
        return true;
    }
};

template <bool GATHER, class Epi, class Sched>
DEV void gemm_phase(LAS unsigned char* lds, const int K, const Sched& S, const Epi& E, int tid_) {
    const int tid = tid_, wid = __builtin_amdgcn_readfirstlane(tid >> 6), lane = tid & 63, wr = wid >> 2, wc = wid & 3, fr = lane & 15, fq = lane >> 4;
    const int nt = K / BK;
    unsigned voff[2];
#pragma unroll
    for (int i = 0; i < 2; ++i) { int R, C; stage_rc(tid * 16 + i * 8192, R, C); voff[i] = (unsigned)(R * K + C) * 2u; }
    unsigned gA[2][2];
    auto load_gather = [&](const Unit& u, unsigned (&g)[2][2]) {
        int tz = tid; asm volatile("" : "+v"(tz));
#pragma unroll
        for (int hh = 0; hh < 2; ++hh)
#pragma unroll
            for (int i = 0; i < 2; ++i) { int R, C; stage_rc(tz * 16 + i * 8192, R, C); int idx = hh * HALF + R; if (idx >= u.gcnt) idx = u.gcnt - 1; g[hh][i] = u.gl[idx] * (unsigned)(K * 2) + (unsigned)C * 2u; }
    };
    const size_t kstep = (size_t)(BK * 2);
    const size_t hstep = (size_t)HALF * K * 2;
    const unsigned ldsw = (unsigned)wid * 1024u;
    const int aoff = lds_byte(wr * 64 + fr, fq * 8), boff = lds_byte(wc * 32 + fr, fq * 8);
#define PG8_SA(b, h) (((b) * 2 + (h)) * HTB)
#define PG8_SB(b, h) ((4 + (b) * 2 + (h)) * HTB)
#define PG8_STAGE(bufoff, gbase) do { _Pragma("unroll") for (int _i = 0; _i < 2; ++_i) \
        __builtin_amdgcn_global_load_lds((const unsigned*)((const char*)(gbase) + voff[_i]), (LAS unsigned*)(lds + (bufoff) + ldsw + _i * 8192), 16, 0, 0); } while (0)
#define PG8_STAGE_A(bufoff, gbase, hsel, gsel) do { if (GATHER) { _Pragma("unroll") for (int _i = 0; _i < 2; ++_i) \
        __builtin_amdgcn_global_load_lds((const unsigned*)((const char*)(gbase) + (gsel)[hsel][_i]), (LAS unsigned*)(lds + (bufoff) + ldsw + _i * 8192), 16, 0, 0); } \
        else PG8_STAGE(bufoff, (gbase) + (hsel) * hstep); } while (0)
#define PG8_LDA(dst, b, h) do { _Pragma("unroll") for (int m = 0; m < 4; ++m) _Pragma("unroll") for (int k = 0; k < 2; ++k) dst[m][k] = *(const LAS bf16x8*)(lds + PG8_SA(b, h) + aoff + m * 2048 + k * 1024); } while (0)
#define PG8_LDB(dst, b, h) do { _Pragma("unroll") for (int n = 0; n < 2; ++n) _Pragma("unroll") for (int k = 0; k < 2; ++k) dst[n][k] = *(const LAS bf16x8*)(lds + PG8_SB(b, h) + boff + n * 2048 + k * 1024); } while (0)
#define PG8_MMA(ai, bj, At, Bt) do { __builtin_amdgcn_s_setprio(1); _Pragma("unroll") for (int m = 0; m < 4; ++m) _Pragma("unroll") for (int n = 0; n < 2; ++n) _Pragma("unroll") for (int k = 0; k < 2; ++k) \
        acc[ai][bj][m][n] = __builtin_amdgcn_mfma_f32_16x16x32_bf16(Bt[n][k], At[m][k], acc[ai][bj][m][n], 0, 0, 0); __builtin_amdgcn_s_setprio(0); } while (0)
#define PG8_WAIT_V(n) asm volatile("s_waitcnt vmcnt(" #n ")" ::: "memory")
#define PG8_WAIT_L(n) asm volatile("s_waitcnt lgkmcnt(" #n ")" ::: "memory")
#define PG8_BAR __builtin_amdgcn_s_barrier()
#define PG8_SCHED __builtin_amdgcn_sched_barrier(0)
    Unit cur, nxt; int ui = 0;
    if (!S.next(0, cur)) return;
    f32x4 acc[2][2][4][2];
#pragma unroll
    for (int a = 0; a < 2; ++a)
#pragma unroll
        for (int b = 0; b < 2; ++b)
#pragma unroll
            for (int m = 0; m < 4; ++m)
#pragma unroll
                for (int n = 0; n < 2; ++n) acc[a][b][m][n] = (f32x4){0.f, 0.f, 0.f, 0.f};
    bf16x8 At[4][2], B0[2][2], B1[2][2];
    const char* cA = cur.a; const char* cB = cur.b;
    if (GATHER) { load_gather(cur, gA); }
    PG8_STAGE(PG8_SB(0, 0), cB); PG8_STAGE_A(PG8_SA(0, 0), cA, 0, gA); PG8_STAGE(PG8_SB(0, 1), cB + hstep); PG8_STAGE_A(PG8_SA(0, 1), cA, 1, gA);
    if (wr == 1) PG8_BAR;
    PG8_WAIT_V(4); PG8_BAR;
    PG8_STAGE(PG8_SB(1, 0), cB + kstep); PG8_STAGE_A(PG8_SA(1, 0), cA + kstep, 0, gA); PG8_STAGE(PG8_SB(1, 1), cB + hstep + kstep);
    PG8_WAIT_V(6); PG8_BAR;
    for (;;) {
        const bool has_next = S.next(ui + 1, nxt);
        const char* nA = has_next ? nxt.a : cA; const char* nB = has_next ? nxt.b : cB;

        for (int t = 0; t < nt; t += 2) {
            const bool last = (t == nt - 2);
            const char* a1 = cA + (size_t)(t + 1) * kstep;
            const char* a2 = last ? nA : cA + (size_t)(t + 2) * kstep; const char* b2 = last ? nB : cB + (size_t)(t + 2) * kstep;
            const char* a3 = a2 + kstep; const char* b3 = b2 + kstep;
            PG8_LDB(B0, 0, 0); PG8_SCHED; PG8_LDA(At, 0, 0); PG8_STAGE_A(PG8_SA(1, 1), a1, 1, gA);
            if (GATHER && last && has_next) load_gather(nxt, gA);
            PG8_WAIT_L(8); PG8_BAR; PG8_WAIT_L(0); PG8_MMA(0, 0, At, B0); PG8_BAR; PG8_SCHED;
            PG8_LDB(B1, 0, 1); PG8_STAGE(PG8_SB(0, 0), b2);
            PG8_BAR; PG8_WAIT_L(0); PG8_MMA(0, 1, At, B1); PG8_BAR;
            PG8_LDA(At, 0, 1); PG8_STAGE_A(PG8_SA(0, 0), a2, 0, gA);
            PG8_BAR; PG8_WAIT_L(0); PG8_MMA(1, 0, At, B0); PG8_BAR; PG8_SCHED;
            PG8_STAGE(PG8_SB(0, 1), b2 + hstep);
            PG8_WAIT_V(6); PG8_BAR; PG8_MMA(1, 1, At, B1); PG8_BAR;
            PG8_LDB(B0, 1, 0); PG8_SCHED; PG8_LDA(At, 1, 0); PG8_STAGE_A(PG8_SA(0, 1), a2, 1, gA);
            PG8_WAIT_L(8); PG8_BAR; PG8_WAIT_L(0); PG8_MMA(0, 0, At, B0); PG8_BAR; PG8_SCHED;
            PG8_LDB(B1, 1, 1); PG8_STAGE(PG8_SB(1, 0), b3);
            PG8_BAR; PG8_WAIT_L(0); PG8_MMA(0, 1, At, B1); PG8_BAR;
            PG8_LDA(At, 1, 1); PG8_STAGE_A(PG8_SA(1, 0), a3, 0, gA);
            PG8_BAR; PG8_WAIT_L(0); PG8_MMA(1, 0, At, B0); PG8_BAR; PG8_SCHED;
            PG8_STAGE(PG8_SB(1, 1), b3 + hstep);
            PG8_WAIT_V(6); PG8_BAR; PG8_MMA(1, 1, At, B1); PG8_BAR;
        }
        E(acc, cur, wr, wc, fr, fq);
        if (!has_next) break;
#pragma unroll
        for (int a = 0; a < 2; ++a)
#pragma unroll
            for (int b = 0; b < 2; ++b)
#pragma unroll
                for (int m = 0; m < 4; ++m)
#pragma unroll
                    for (int n = 0; n < 2; ++n) acc[a][b][m][n] = (f32x4){0.f, 0.f, 0.f, 0.f};
        cur = nxt; cA = nA; cB = nB; ++ui;
    }
    PG8_WAIT_V(0);
    if (wr == 0) PG8_BAR;
    PG8_BAR;
#undef PG8_SA
#undef PG8_SB
#undef PG8_STAGE
#undef PG8_STAGE_A
#undef PG8_LDA
#undef PG8_LDB
#undef PG8_MMA
#undef PG8_WAIT_V
#undef PG8_WAIT_L
#undef PG8_BAR
#undef PG8_SCHED
}
}
using pg8::Unit;

struct EpiF32Store {
    float* C; int ldc;
    DEV void operator()(const f32x4 (&acc)[2][2][4][2], const Unit& u, int wr, int wc, int fr, int fq) const {
        const int row0 = u.row0 + wr * 64 + fr, col0 = u.col0 + wc * 32 + 4 * fq;
#pragma unroll
        for (int ai = 0; ai < 2; ++ai)
#pragma unroll
            for (int m = 0; m < 4; ++m) { float* rowp = C + (size_t)(row0 + ai * 128 + m * 16) * ldc + col0;
#pragma unroll
                for (int bj = 0; bj < 2; ++bj)
#pragma unroll
                    for (int n = 0; n < 2; ++n) *(f32x4*)(rowp + bj * 128 + n * 16) = acc[ai][bj][m][n]; }
    }
};
struct EpiQKNorm {
    u16* qkv; const float* gains  ; float* P; char* img;
    DEV void operator()(const f32x4 (&acc)[2][2][4][2], const Unit& u, int wr, int wc, int fr, int fq) const {
        const int c0 = u.col0;
        const int kind = c0 < 1024 ? 0 : c0 < 2048 ? 1 : c0 < 3072 ? 2 : c0 < 4096 ? 3 : c0 < 4352 ? 4 : 5;
        const bool isctx = (u.row0 % RB) == 0;
        const bool normed = (kind == 0 || kind == 1 || kind == 3 || kind == 4);
        const bool wide = kind >= 3;
        if (normed) {
#pragma unroll
            for (int ai = 0; ai < 2; ++ai)
#pragma unroll
                for (int m = 0; m < 4; ++m)
#pragma unroll
                    for (int bj = 0; bj < 2; ++bj) {
                        const f32x4 a = acc[ai][bj][m][0], b = acc[ai][bj][m][1];
                        float ss = a[0] * a[0] + a[1] * a[1] + a[2] * a[2] + a[3] * a[3] + b[0] * b[0] + b[1] * b[1] + b[2] * b[2] + b[3] * b[3];
                        ss += __shfl_xor(ss, 16, 64); ss += __shfl_xor(ss, 32, 64);
                        if (fq == 0) P[(ai * 128 + wr * 64 + m * 16 + fr) * 8 + bj * 4 + wc] = ss;
                    }
        }
        asm volatile("s_waitcnt lgkmcnt(0)" ::: "memory"); __builtin_amdgcn_s_barrier(); asm volatile("" ::: "memory");
        const int row0 = u.row0 + wr * 64 + fr, col0 = c0 + wc * 32 + 4 * fq;
        const float* gp = gains + (kind == 0 ? 0 : kind == 1 ? 128 : kind == 3 ? 256 : 384);
        const int dbase = wide ? (wc * 32 + 4 * fq) : ((wc & 1) * 32 + 4 * fq);
        const float nfi = wide ? (1.f / 32.f) : (1.f / 16.f);
        const bool rowang = wide ? (wc < 2) : ((wc & 1) == 0);
        const float qs = kind == 0 ? 0.125f * LOG2E : kind == 3 ? 0.08838834764831845f * LOG2E : 1.f;
#pragma unroll
        for (int n = 0; n < 2; ++n) {
            float g[4], inv[2];
#pragma unroll
            for (int j = 0; j < 4; ++j) g[j] = normed ? gp[dbase + 16 * n + j] : 1.f;
#pragma unroll
            for (int j2 = 0; j2 < 2; ++j2) { const int f = (wide ? 16 * (wc & 1) : 0) + 8 * n + 2 * fq + j2; inv[j2] = exp2f(-13.287712379549449f * (float)f * nfi); }
#pragma unroll
            for (int ai = 0; ai < 2; ++ai)
#pragma unroll
                for (int m = 0; m < 4; ++m) {
                    const int rl = ai * 128 + wr * 64 + m * 16 + fr, row = row0 + ai * 128 + m * 16;
                    const int pos = (row % RB) - CTXL;
                    const float pa = (float)(rowang ? (pos >> 6) : (pos & 63));
                    u16* rowp = qkv + (size_t)row * AIN + col0 + n * 16;
#pragma unroll
                    for (int bj = 0; bj < 2; ++bj) {
                        float rs = 1.f;
                        if (normed) {
                            const float* pp = P + rl * 8 + bj * 4;
                            const float ss = wide ? (pp[0] + pp[1] + pp[2] + pp[3]) : (pp[wc & 2] + pp[(wc & 2) + 1]);
                            rs = rsqrtf(ss * (wide ? (1.f / 128.f) : (1.f / 64.f)) + EPSN);
                        }
                        const f32x4 v = acc[ai][bj][m][n];
                        float o[4];
#pragma unroll
                        for (int j = 0; j < 4; ++j) o[j] = v[j] * rs * g[j];
                        if (normed && !isctx) {
#pragma unroll
                            for (int j2 = 0; j2 < 2; ++j2) {
                                float sn, cs; __sincosf(pa * inv[j2], &sn, &cs);
                                const float x0 = o[2 * j2], x1 = o[2 * j2 + 1];
                                o[2 * j2] = x0 * cs - x1 * sn; o[2 * j2 + 1] = x0 * sn + x1 * cs;
                            }
                        }
                        u32x2 w; w.x = cvt_pk_bf16(o[0] * qs, o[1] * qs); w.y = cvt_pk_bf16(o[2] * qs, o[3] * qs);
                        const int T = row >> 6, key = row & 63;
                        if (kind == 0 || kind == 3) *(u32x2*)(rowp + bj * 128) = w;
                        else if (kind == 1) {
                            const int sh = ((c0 - 1024) >> 6) + 2 * bj + (wc >> 1), g = 4 * (wc & 1) + 2 * n + (fq >> 1);
                            *(u32x2*)(img + IMG_KD + ((size_t)(sh * NTILE + T) << 13) + ((g * 64 + (key ^ (g & 7))) << 4) + (fq & 1) * 8) = w;
                        } else if (kind == 4) {
                            const int g = 4 * wc + 2 * n + (fq >> 1);
                            *(u32x2*)(img + IMG_KS + ((size_t)(bj * NTILE + T) << 14) + ((g * 64 + (key ^ (g & 7))) << 4) + (fq & 1) * 8) = w;
                        } else {
                            const int hd = kind == 2 ? ((c0 - 2048) >> 7) + bj : bj;
                            char* vb = img + (kind == 2 ? IMG_VD : IMG_VS) + ((size_t)(hd * NTILE + T) << 14);
                            const int kk = key & 15, cidx = 2 * (key >> 4) + ((kk >> 2) & 1), eb = (kk >> 3) * 8 + (kk & 3) * 2;
                            const int d0 = 32 * wc + 16 * n + 4 * fq;
#pragma unroll
                            for (int j = 0; j < 4; ++j) { const int d = d0 + j;
                                *(u16*)(vb + ((cidx * 128 + (d ^ ((d >> 3) & 7))) << 4) + eb) = (u16)((j & 1) ? ((j >> 1 ? w.y : w.x) >> 16) : ((j >> 1 ? w.y : w.x) & 0xffffu)); }
                        }
                    }
                    if (m & 1) __builtin_amdgcn_sched_barrier(0);
                }
        }
    }
};
struct EpiResid {
    const float* xi; float* xo; const float* gmod; const float* bias;
    DEV void operator()(const f32x4 (&acc)[2][2][4][2], const Unit& u, int wr, int wc, int fr, int fq) const {
        const int row0 = u.row0 + wr * 64 + fr, col0 = u.col0 + wc * 32 + 4 * fq;
        const float* gm = gmod + (size_t)(u.row0 / SEQ) * 12288;
        f32x4 gv[2][2], bv[2][2];
#pragma unroll
        for (int bj = 0; bj < 2; ++bj)
#pragma unroll
            for (int n = 0; n < 2; ++n) { gv[bj][n] = *(const f32x4*)(gm + col0 + bj * 128 + n * 16); bv[bj][n] = bias ? *(const f32x4*)(bias + col0 + bj * 128 + n * 16) : (f32x4){0.f, 0.f, 0.f, 0.f}; }
        const float* __restrict__ xin = xi; float* __restrict__ xout = xo;
#pragma unroll
        for (int ai = 0; ai < 2; ++ai)
#pragma unroll
            for (int mp = 0; mp < 2; ++mp) {
                f32x4 xv[2][2][2];
#pragma unroll
                for (int mm = 0; mm < 2; ++mm) { const size_t ro = (size_t)(row0 + ai * 128 + (mp * 2 + mm) * 16) * DM + col0;
#pragma unroll
                    for (int bj = 0; bj < 2; ++bj)
#pragma unroll
                        for (int n = 0; n < 2; ++n) xv[mm][bj][n] = *(const f32x4*)(xin + ro + bj * 128 + n * 16); }
                __builtin_amdgcn_sched_barrier(0);
#pragma unroll
                for (int mm = 0; mm < 2; ++mm) { const int m = mp * 2 + mm; const size_t ro = (size_t)(row0 + ai * 128 + m * 16) * DM + col0;
#pragma unroll
                    for (int bj = 0; bj < 2; ++bj)
#pragma unroll
                        for (int n = 0; n < 2; ++n) *(f32x4*)(xout + ro + bj * 128 + n * 16) = xv[mm][bj][n] + gv[bj][n] * (acc[ai][bj][m][n] + bv[bj][n]); }
            }
    }
};
struct EpiMoe1 {
    u16* act;
    DEV void operator()(const f32x4 (&acc)[2][2][4][2], const Unit& u, int wr, int wc, int fr, int fq) const {
        const int row0 = u.row0 + wr * 64 + fr, col0 = (u.col0 >> 1) + wc * 32 + 4 * fq;
#pragma unroll
        for (int ai = 0; ai < 2; ++ai)
#pragma unroll
            for (int m = 0; m < 4; ++m) { u16* rowp = act + (size_t)(row0 + ai * 128 + m * 16) * FF + col0;
#pragma unroll
                for (int n = 0; n < 2; ++n) { const f32x4 g = acc[ai][0][m][n], up = acc[ai][1][m][n];
                    u32x2 o; o.x = cvt_pk_bf16(silu(g[0]) * up[0], silu(g[1]) * up[1]); o.y = cvt_pk_bf16(silu(g[2]) * up[2], silu(g[3]) * up[3]);
                    *(u32x2*)(rowp + n * 16) = o; } }
    }
};
struct EpiBf16Store {
    u16* O; int ldc; const float* rowbias;
    DEV void operator()(const f32x4 (&acc)[2][2][4][2], const Unit& u, int wr, int wc, int fr, int fq) const {
        const int row0 = u.row0 + wr * 64 + fr, col0 = u.col0 + wc * 32 + 4 * fq;
        float rbv[2][4];
#pragma unroll
        for (int ai = 0; ai < 2; ++ai)
#pragma unroll
            for (int m = 0; m < 4; ++m) rbv[ai][m] = rowbias ? rowbias[row0 + ai * 128 + m * 16] : 0.f;
#pragma unroll
        for (int ai = 0; ai < 2; ++ai)
#pragma unroll
            for (int m = 0; m < 4; ++m) { const int row = row0 + ai * 128 + m * 16; u16* rowp = O + (size_t)row * ldc + col0; const float rb = rbv[ai][m];
#pragma unroll
                for (int bj = 0; bj < 2; ++bj)
#pragma unroll
                    for (int n = 0; n < 2; ++n) { const f32x4 v = acc[ai][bj][m][n];
                        u32x2 o; o.x = cvt_pk_bf16(v[0] + rb, v[1] + rb); o.y = cvt_pk_bf16(v[2] + rb, v[3] + rb);
                        *(u32x2*)(rowp + bj * 128 + n * 16) = o; } }
    }
};
struct EpiFilter {
    float* filtT;
    DEV void operator()(const f32x4 (&acc)[2][2][4][2], const Unit& u, int wr, int wc, int fr, int fq) const {
        const int row0 = u.row0 + wr * 64 + fr, col0 = u.col0 + wc * 32 + 4 * fq;
        const float min_decay = -3.0701134573253946f, max_decay = -15.350567286626973f;
#pragma unroll
        for (int ai = 0; ai < 2; ++ai)
#pragma unroll
            for (int m = 0; m < 4; ++m) { const int row = row0 + ai * 128 + m * 16;
                const float delta = fabsf(min_decay + (max_decay - min_decay) * (float)(row & 2047) / 2047.f) * (1.f / (float)(SEQ - 1));
                float* rowp = filtT + (size_t)row * SEQ + col0;
#pragma unroll
                for (int bj = 0; bj < 2; ++bj)
#pragma unroll
                    for (int n = 0; n < 2; ++n) { const int c = col0 + bj * 128 + n * 16; f32x4 v = acc[ai][bj][m][n];
#pragma unroll
                        for (int j = 0; j < 4; ++j) v[j] *= __expf(-(float)(c + j) * delta);
                        *(f32x4*)(rowp + bj * 128 + n * 16) = v; } }
    }
};

DEV void row_load(const float* p, float4 (&v)[8], int lane) {
#pragma unroll
    for (int i = 0; i < 8; ++i) v[i] = *(const float4*)(p + 4 * lane + 256 * i);
}
DEV float row_rstd(const float4 (&v)[8]) {
    float ss = 0.f;
#pragma unroll
    for (int i = 0; i < 8; ++i) ss += v[i].x * v[i].x + v[i].y * v[i].y + v[i].z * v[i].z + v[i].w * v[i].w;
    ss = wave_sum(ss);
    return rsqrtf(ss * (1.f / DM) + EPSN);
}
DEV void row_modulate(float4 (&v)[8], float rstd, const float* g, const float* sc, const float* sh, int lane) {
#pragma unroll
    for (int i = 0; i < 8; ++i) {
        const int c = 4 * lane + 256 * i;
        const float4 gg = *(const float4*)(g + c), s = *(const float4*)(sc + c), b = *(const float4*)(sh + c);
        v[i].x = v[i].x * rstd * gg.x * (1.f + s.x) + b.x;
        v[i].y = v[i].y * rstd * gg.y * (1.f + s.y) + b.y;
        v[i].z = v[i].z * rstd * gg.z * (1.f + s.z) + b.z;
        v[i].w = v[i].w * rstd * gg.w * (1.f + s.w) + b.w;
    }
}
DEV void row_store_bf16(u16* p, const float4 (&v)[8], int lane) {
#pragma unroll
    for (int i = 0; i < 8; ++i) {
        u32x2 o; o.x = cvt_pk_bf16(v[i].x, v[i].y); o.y = cvt_pk_bf16(v[i].z, v[i].w);
        *(u32x2*)(p + 4 * lane + 256 * i) = o;
    }
}

template <class RM> DEV void conv_tile(const float* src, int N, int k0, int n0, u16* dst, int KP, RM rowmap, float* tl  , int tid_) {
    const int t = tid_;
    {
        const int k = t >> 3, nc = (t & 7) * 8;
        const float4 a = *(const float4*)(src + (size_t)(k0 + k) * N + n0 + nc), b = *(const float4*)(src + (size_t)(k0 + k) * N + n0 + nc + 4);
        float* d = tl + k * 65 + nc;
        d[0] = a.x; d[1] = a.y; d[2] = a.z; d[3] = a.w; d[4] = b.x; d[5] = b.y; d[6] = b.z; d[7] = b.w;
    }
    __syncthreads();
    {
        const int n = t >> 3, kc = (t & 7) * 8;
        const float* s = tl + kc * 65 + n;
        u32x4 o;
        o.x = cvt_pk_bf16(s[0 * 65], s[1 * 65]); o.y = cvt_pk_bf16(s[2 * 65], s[3 * 65]); o.z = cvt_pk_bf16(s[4 * 65], s[5 * 65]); o.w = cvt_pk_bf16(s[6 * 65], s[7 * 65]);
        *(u32x4*)(dst + (size_t)rowmap(n0 + n) * KP + k0 + kc) = o;
    }
    __syncthreads();
}
DEV void convert_moe_layer(const Params& p, char* lds, int layer, int tid_) {
    float* tl = (float*)lds;
    const int per_e = 512 + 512 + 512;
    for (int j = blockIdx.x; j < NEXP * per_e; j += gridDim.x) {
        const int e = j / per_e, r = j % per_e;
        const size_t eo = (size_t)layer * NEXP + e;
        if (r < 1024) {
            const int up = r >= 512, rr = r & 511, kt = rr >> 4, nt = rr & 15;
            const float* src = (up ? p.w_up : p.w_gate) + eo * DM * FF;
            conv_tile(src, FF, kt * 64, nt * 64, p.wt_gu + (size_t)e * 2048 * 2048, 2048, [&](int n) { return ((n >> 7) << 8) + (n & 127) + (up ? 128 : 0); }, tl, tid_);
        } else {
            const int rr = r - 1024, kt = rr >> 5, nt = rr & 31;
            conv_tile(p.w_down + eo * FF * DM, DM, kt * 64, nt * 64, p.wt_dn + (size_t)e * 2048 * 1024, 1024, [&](int n) { return n; }, tl, tid_);
        }
    }
}
struct CvtBlk {
    float4 v[8]; u16* dst; unsigned dstride;
    DEV void issue(const float* src, unsigned N, u16* dstm, unsigned KP, unsigned w) {
        const unsigned nb8 = N >> 5, rest = w >> 6, k8 = (w & 7u) | ((rest / nb8) << 3), n4 = ((w >> 3) & 7u) | ((rest % nb8) << 3);
        const float* sp = src + (size_t)(k8 * 8u) * N + n4 * 4u;
        dst = dstm + (size_t)(n4 * 4u) * KP + k8 * 8u; dstride = KP;
#pragma unroll
        for (int j = 0; j < 8; ++j) { const f32x4 q_ = __builtin_nontemporal_load((const f32x4*)(sp + (size_t)j * N)); v[j] = make_float4(q_[0], q_[1], q_[2], q_[3]); }
    }
    DEV void finish() {
        u32x4 o;
        o.x = cvt_pk_bf16(v[0].x, v[1].x); o.y = cvt_pk_bf16(v[2].x, v[3].x); o.z = cvt_pk_bf16(v[4].x, v[5].x); o.w = cvt_pk_bf16(v[6].x, v[7].x); *(u32x4*)(dst) = o;
        o.x = cvt_pk_bf16(v[0].y, v[1].y); o.y = cvt_pk_bf16(v[2].y, v[3].y); o.z = cvt_pk_bf16(v[4].y, v[5].y); o.w = cvt_pk_bf16(v[6].y, v[7].y); *(u32x4*)(dst + dstride) = o;
        o.x = cvt_pk_bf16(v[0].z, v[1].z); o.y = cvt_pk_bf16(v[2].z, v[3].z); o.z = cvt_pk_bf16(v[4].z, v[5].z); o.w = cvt_pk_bf16(v[6].z, v[7].z); *(u32x4*)(dst + 2 * dstride) = o;
        o.x = cvt_pk_bf16(v[0].w, v[1].w); o.y = cvt_pk_bf16(v[2].w, v[3].w); o.z = cvt_pk_bf16(v[4].w, v[5].w); o.w = cvt_pk_bf16(v[6].w, v[7].w); *(u32x4*)(dst + 3 * dstride) = o;
    }
};
DEV void cvt_dense_matrix(const float* src, unsigned K, unsigned N, u16* dst, unsigned KP, unsigned gtid, unsigned gstride) {
    const unsigned nblk = (K >> 3) * (N >> 2);
    CvtBlk a, b, c;
    unsigned w = gtid;
#pragma unroll 1
    for (; w + 2 * gstride < nblk; w += 3 * gstride) { a.issue(src, N, dst, KP, w); b.issue(src, N, dst, KP, w + gstride); c.issue(src, N, dst, KP, w + 2 * gstride); a.finish(); b.finish(); c.finish(); }
#pragma unroll 1
    for (; w < nblk; w += gstride) { a.issue(src, N, dst, KP, w); a.finish(); }
}
DEV void convert_dense(const Params& p, char* lds, int tid_) {
    const unsigned gtid = blockIdx.x * NTHR + tid_, gstride = gridDim.x * NTHR;
    cvt_dense_matrix(p.attn_w_in, DM, AIN, p.wt_attn_in, DM, gtid, gstride);
    cvt_dense_matrix(p.attn_w_out, DM, DM, p.wt_attn_out, DM, gtid, gstride);
    cvt_dense_matrix(p.hy_w_in, DM, 6144, p.wt_hy_in, DM, gtid, gstride);
    cvt_dense_matrix(p.hy_w_out, DM, DM, p.wt_hy_out, DM, gtid, gstride);
    cvt_dense_matrix(p.flt_w3, 64, 8192, p.wt_w3, 256, gtid, gstride);
    for (int i = blockIdx.x * NTHR + tid_; i < 8192 * 24; i += gridDim.x * NTHR) {
        const int row = i / 24, ch = i % 24;
        *(u32x4*)(p.wt_w3 + (size_t)row * 256 + 64 + ch * 8) = (u32x4){0u, 0u, 0u, 0u};
    }
}

struct CvtJob {
    float4 v[8]; u16* dst; unsigned dstride;
    DEV void issue(const Params& p, int layer, unsigned id) {
        if (id >= NEXP * 3u * 65536u) id = NEXP * 3u * 65536u - 1u;
        const unsigned me = id >> 16, w = id & 65535u, e = me / 3u, mat = me - 3u * e;
        const size_t eo = (size_t)layer * NEXP + e;
        const float* src; unsigned ldn;
        if (mat < 2u) { const unsigned k8 = (w & 7u) | ((w >> 11) << 3), n4 = ((w >> 3) & 7u) | (((w >> 6) & 31u) << 3), n = n4 * 4u;
            src = (mat ? p.w_up : p.w_gate) + eo * DM * FF + (size_t)(k8 * 8u) * FF + n; ldn = FF;
            dst = p.wt_gu + (size_t)e * 2048 * 2048 + (size_t)(((n >> 7) << 8) + (n & 127u) + (mat ? 128u : 0u)) * 2048 + k8 * 8u; dstride = 2048; }
        else { const unsigned k8 = (w & 7u) | ((w >> 12) << 3), n4 = ((w >> 3) & 7u) | (((w >> 6) & 63u) << 3), n = n4 * 4u;
            src = p.w_down + eo * FF * DM + (size_t)(k8 * 8u) * DM + n; ldn = DM;
            dst = p.wt_dn + (size_t)e * 2048 * 1024 + (size_t)n * 1024 + k8 * 8u; dstride = 1024; }
#pragma unroll
        for (int j = 0; j < 8; ++j) { const f32x4 q_ = __builtin_nontemporal_load((const f32x4*)(src + (size_t)j * ldn)); v[j] = make_float4(q_[0], q_[1], q_[2], q_[3]); }
    }
    DEV void finish() {
        u32x4 o;
        o.x = cvt_pk_bf16(v[0].x, v[1].x); o.y = cvt_pk_bf16(v[2].x, v[3].x); o.z = cvt_pk_bf16(v[4].x, v[5].x); o.w = cvt_pk_bf16(v[6].x, v[7].x); *(u32x4*)(dst) = o;
        o.x = cvt_pk_bf16(v[0].y, v[1].y); o.y = cvt_pk_bf16(v[2].y, v[3].y); o.z = cvt_pk_bf16(v[4].y, v[5].y); o.w = cvt_pk_bf16(v[6].y, v[7].y); *(u32x4*)(dst + dstride) = o;
        o.x = cvt_pk_bf16(v[0].z, v[1].z); o.y = cvt_pk_bf16(v[2].z, v[3].z); o.z = cvt_pk_bf16(v[4].z, v[5].z); o.w = cvt_pk_bf16(v[6].z, v[7].z); *(u32x4*)(dst + 2 * dstride) = o;
        o.x = cvt_pk_bf16(v[0].w, v[1].w); o.y = cvt_pk_bf16(v[2].w, v[3].w); o.z = cvt_pk_bf16(v[4].w, v[5].w); o.w = cvt_pk_bf16(v[6].w, v[7].w); *(u32x4*)(dst + 3 * dstride) = o;
    }
};
constexpr unsigned CVT_ROUTE_JOBS0 = 16;
constexpr unsigned CVT_ROUTE_JOBS = 16;
DEV void phase_prologue(const Params& p, char* lds, int tid_) {
    const int t = tid_, lane = t & 63, w = t >> 6;
    const int G = gridDim.x, bid = blockIdx.x;
    if (bid == 0 && t < 64) p.cnt[t] = 0u;
    if (bid == 1 && t < 128) { p.gains[t] = t < 64 ? p.diff_q_g[t] : 0.f; p.gains[128 + t] = t < 64 ? p.diff_k_g[t] : 0.f; p.gains[256 + t] = p.swa_q_g[t]; p.gains[384 + t] = p.swa_k_g[t]; }
    if (bid < 192) {
        float* s = (float*)lds;
        float* part = (float*)(lds + 40960);
        float cv[5 * DM / NTHR];
#pragma unroll
        for (int q = 0; q < 5 * DM / NTHR; ++q) { const int r = q / (DM / NTHR), k = (q % (DM / NTHR)) * NTHR + t; cv[q] = r < 4 ? p.c[r * DM + k] : p.c_ctx[k]; }
#pragma unroll
        for (int q = 0; q < 5 * DM / NTHR; ++q) s[q * NTHR + t] = silu(cv[q]);
        __syncthreads();
        for (int u = bid; u < 192; u += G) {
            const int layer = u / 96, col = (u % 96) * 128 + 2 * lane;
            const float* W = p.ada_w + (size_t)layer * DM * 12288 + col;
            float acc[5][2];
#pragma unroll
            for (int r = 0; r < 5; ++r) { acc[r][0] = 0.f; acc[r][1] = 0.f; }
            const int k0 = w * 256;
            for (int k = k0; k < k0 + 256; k += 16) {
                float2 wv[16];
#pragma unroll
                for (int j = 0; j < 16; ++j) wv[j] = *(const float2*)(W + (size_t)(k + j) * 12288);
#pragma unroll
                for (int j = 0; j < 16; ++j)
#pragma unroll
                    for (int r = 0; r < 5; ++r) { const float sv = s[r * DM + k + j]; acc[r][0] += sv * wv[j].x; acc[r][1] += sv * wv[j].y; }
            }
#pragma unroll
            for (int r = 0; r < 5; ++r) { part[(w * 5 + r) * 128 + 2 * lane] = acc[r][0]; part[(w * 5 + r) * 128 + 2 * lane + 1] = acc[r][1]; }
            __syncthreads();
            if (t < 128) {
                const int cc = (u % 96) * 128 + t;
                const float bias = p.ada_b[layer * 12288 + cc];
#pragma unroll
                for (int r = 0; r < 5; ++r) {
                    float sum = bias;
#pragma unroll
                    for (int ww = 0; ww < 8; ++ww) sum += part[(ww * 5 + r) * 128 + t];
                    p.mod[((size_t)layer * 5 + r) * 12288 + cc] = sum;
                }
            }
            __syncthreads();
        }
    }
    for (int j = bid * NTHR + t; j < 8192; j += G * NTHR) {
        float sn, cs; sincospif((float)j * (2.f / 8192.f), &sn, &cs);
        p.tw[j] = make_float2(cs, -sn);
        if (j < 4096) { const int k = j >> 8, tt = j & 255; sincospif((float)((tt * k) & 4095) * (2.f / 4096.f), &sn, &cs); p.tw[8192 + j] = make_float2(cs, -sn); }
        if (j < 256)  { const int k = j >> 4, jj = j & 15;  sincospif((float)((jj * k) & 255) * (2.f / 256.f), &sn, &cs);  p.tw[12288 + j] = make_float2(cs, -sn); }
    }
    {
        __syncthreads();
        float* a1s = (float*)lds;
        const int u = lane, sub = w;
        for (int n0 = bid * 8; n0 < SEQ; n0 += G * 8) {
            const int n = n0 + sub;
            const float tt = (float)n / (float)(SEQ - 1);
            const float wv = 6.283185307179586f * (float)n / (float)SEQ;
            float acc = p.flt_b1[u] + tt * p.flt_w1[0 * 64 + u];
#pragma unroll
            for (int j = 0; j < 16; ++j) {
                const float f = 1e-4f + (float)j * ((15.f - 1e-4f) / 15.f);
                const float a = wv * f;
                acc += cosf(a) * p.flt_w1[(1 + j) * 64 + u] - sinf(a) * p.flt_w1[(17 + j) * 64 + u];
            }
            const float a1 = sinf(p.flt_f1[u] * acc);
            __syncthreads();
            a1s[sub * 64 + u] = a1;
            __syncthreads();
            float acc2 = p.flt_b2[u];
#pragma unroll 8
            for (int v = 0; v < 64; ++v) acc2 += a1s[sub * 64 + v] * p.flt_w2[v * 64 + u];
            p.a2p[n * 256 + u] = f2bf(sinf(p.flt_f2[u] * acc2));
            p.a2p[n * 256 + 64 + u] = 0; p.a2p[n * 256 + 128 + u] = 0; p.a2p[n * 256 + 192 + u] = 0;
        }
        __syncthreads();
    }
    convert_dense(p, lds, tid_);
    {
        const unsigned gtid = blockIdx.x * NTHR + tid_, gstride = gridDim.x * NTHR, njobs = (NEXP * 3u * 65536u + gstride - 1u) / gstride;
        CvtJob ja, jb, jc;
        unsigned j = CVT_ROUTE_JOBS;
#pragma unroll 1
        for (; j + 3 <= njobs; j += 3) { ja.issue(p, 0, j * gstride + gtid); jb.issue(p, 0, (j + 1) * gstride + gtid); jc.issue(p, 0, (j + 2) * gstride + gtid); ja.finish(); jb.finish(); jc.finish(); }
#pragma unroll 1
        for (; j < njobs; ++j) { ja.issue(p, 0, j * gstride + gtid); ja.finish(); }
    }
}

DEV void phase_norm1_l0(const Params& p, int tid_) {
    const int lane = tid_ & 63, w = tid_ >> 6;
    for (int rr = blockIdx.x * NW + w; rr < NROW; rr += gridDim.x * NW) {
        const int b = rr / RB, i = rr % RB;
        const float* src = i < CTXL ? p.ctx + ((size_t)b * CTXL + i) * DM : p.x + ((size_t)b * SEQ + (i - CTXL)) * DM;
        const float* md = p.mod + (size_t)(i < CTXL ? 4 : b) * 12288;
        float4 v[8]; row_load(src, v, lane);
        const float rstd = row_rstd(v);
        row_modulate(v, rstd, p.norm1_g, md + 2048, md, lane);
        row_store_bf16(p.h + (size_t)rr * DM, v, lane);
    }
}

DEV void phase_qknorm(const Params& p, int tid_) {
    const int lane = tid_ & 63, w = tid_ >> 6;
    const u16* raw = (const u16*)p.regA; u16* qkv = p.regB;
    for (int rr = blockIdx.x; rr < NROW; rr += gridDim.x) {
        const int i = rr % RB;
        const bool isctx = i < CTXL;
        const int pos = i - CTXL, prow = pos >> 6, pcol = pos & 63;
        for (int st = w; st < 36; st += NW) {
            const int c0 = st * 128;
            const int kind = c0 < 1024 ? 0 : c0 < 2048 ? 1 : c0 < 3072 ? 2 : c0 < 4096 ? 3 : c0 < 4352 ? 4 : 5;
            if (isctx && (kind == 0 || kind == 3)) continue;
            const unsigned rv_ = *(const unsigned*)(raw + (size_t)rr * AIN + c0 + 2 * lane);
            const float2 v = make_float2(__builtin_bit_cast(float, rv_ << 16), __builtin_bit_cast(float, rv_ & 0xffff0000u));
            float o0 = v.x, o1 = v.y;
            if (kind == 0 || kind == 1) {
                float ss = v.x * v.x + v.y * v.y;
#pragma unroll
                for (int m = 16; m >= 1; m >>= 1) ss += __shfl_xor(ss, m, 64);
                const float rs = rsqrtf(ss * (1.f / 64.f) + EPSN);
                const float* g = (kind == 0 ? p.diff_q_g : p.diff_k_g) + 2 * (lane & 31);
                o0 = v.x * rs * g[0]; o1 = v.y * rs * g[1];
                if (!isctx) {
                    const int pi = lane & 31;
                    const float inv = exp2f(-13.287712379549449f * (float)(pi & 15) * (1.f / 16.f));
                    const float ang = (float)(pi < 16 ? prow : pcol) * inv;
                    float sn, cs; __sincosf(ang, &sn, &cs);
                    const float a = o0 * cs - o1 * sn, b = o0 * sn + o1 * cs;
                    o0 = a; o1 = b;
                }
                if (kind == 0) { o0 *= 0.125f * LOG2E; o1 *= 0.125f * LOG2E; }
            } else if (kind == 3 || kind == 4) {
                float ss = wave_sum(v.x * v.x + v.y * v.y);
                const float rs = rsqrtf(ss * (1.f / 128.f) + EPSN);
                const float* g = (kind == 3 ? p.swa_q_g : p.swa_k_g) + 2 * lane;
                o0 = v.x * rs * g[0]; o1 = v.y * rs * g[1];
                if (!isctx) {
                    const int pi = lane;
                    const float inv = exp2f(-13.287712379549449f * (float)(pi & 31) * (1.f / 32.f));
                    const float ang = (float)(pi < 32 ? prow : pcol) * inv;
                    float sn, cs; __sincosf(ang, &sn, &cs);
                    const float a = o0 * cs - o1 * sn, b = o0 * sn + o1 * cs;
                    o0 = a; o1 = b;
                }
                if (kind == 3) { o0 *= 0.08838834764831845f * LOG2E; o1 *= 0.08838834764831845f * LOG2E; }
            }
            *(unsigned*)(qkv + (size_t)rr * AIN + c0 + 2 * lane) = cvt_pk_bf16(o0, o1);
        }
    }
}

constexpr int AT_STAGE = 32768, AT_VOFF = 16384;
template <int DQK, bool SWA>
DEV void attn_item(const Params& p, char* lds  , int tl, int sub, int item, float M2, float sink_term_l2, float lam, unsigned (&park)[32]) {
    const int t = tl, lane = t & 63, w = t >> 6, r = lane & 31, h = lane >> 5;
    const u16* qkv = p.regB;
    int b, qb, qcol, kcol, vcol, hs;
    if (!SWA) { qb = (item >> 1) & 31; hs = ((item >> 6) & 7) * 2 + (item & 1); b = item >> 9; qcol = hs * 64; kcol = 1024 + hs * 64; vcol = 2048 + (hs >> 1) * 128; }
    else      { qb = item & 31; hs = (item >> 5) & 7;  b = item >> 8; qcol = 3072 + hs * 128; kcol = 4096 + (hs >> 2) * 128; vcol = 4352 + (hs >> 2) * 128; }
    const size_t brow = (size_t)b * RB;
    int ntile, lo = 0;
    if (!SWA) ntile = RB / 64;
    else { lo = qb * 128 - 128; if (lo < 0) lo = 0; if (lo > SEQ - 384) lo = SEQ - 384; ntile = 10; }
    const char* kimg = (const char*)p.regA + (SWA ? IMG_KS + ((size_t)((hs >> 2) * NTILE) << 14) : IMG_KD + ((size_t)(hs * NTILE) << 13));
    const char* vimg = (const char*)p.regA + (SWA ? IMG_VS + ((size_t)((hs >> 2) * NTILE) << 14) : IMG_VD + ((size_t)((hs >> 1) * NTILE) << 14));
    auto tile_idx = [&](int kt) -> int { if (!SWA) return b * (RB / 64) + kt; return kt < 4 ? b * (RB / 64) + kt : b * (RB / 64) + 4 + (lo >> 6) + (kt - 4); };
    const int ts = SWA ? t : t + sub * 256;
    const int wbase = (ts & ~63) * 16;
    constexpr int PROW = SWA ? 4096 : 8192;
    auto stage = [&](int kt, char* st) {
        const int T = tile_idx(kt);
        const char* kg = kimg + ((size_t)T * (DQK * 128)) + ts * 16;
        const char* vg = vimg + ((size_t)T << 14) + ts * 16;
#pragma unroll
        for (int i = 0; i < DQK * 128 / PROW; ++i) __builtin_amdgcn_global_load_lds((const unsigned*)(kg + i * PROW), (LAS unsigned*)(st + i * PROW + wbase), 16, 0, 0);
#pragma unroll
        for (int i = 0; i < 16384 / PROW; ++i) __builtin_amdgcn_global_load_lds((const unsigned*)(vg + i * PROW), (LAS unsigned*)(st + AT_VOFF + i * PROW + wbase), 16, 0, 0);
    };
    const int qpos = qb * 128 + w * 32 + r;
    const u16* qp = qkv + (brow + CTXL + qpos) * AIN + qcol + 8 * h;
    bf16x8 qf[DQK / 16];
#pragma unroll
    for (int ks = 0; ks < DQK / 16; ++ks) qf[ks] = *(const bf16x8*)(qp + 16 * ks);
    int kb4[4], vb2[2];
#pragma unroll
    for (int j = 0; j < 4; ++j) kb4[j] = ((r ^ (2 * j + h)) << 4) + 1024 * h;
#pragma unroll
    for (int j = 0; j < 2; ++j) vb2[j] = ((r ^ (4 * j + (r >> 3))) << 4) + 2048 * h;
    f32x16 O[4];
#pragma unroll
    for (int i = 0; i < 4; ++i)
#pragma unroll
        for (int e = 0; e < 16; ++e) O[i][e] = 0.f;
    float lsum = 0.f;
    constexpr int NST = SWA ? 2 : 4, PD = NST - 1;
    __syncthreads();
#pragma unroll
    for (int d = 0; d < PD; ++d) stage(d, lds + d * AT_STAGE);
    if (SWA) asm volatile("s_waitcnt vmcnt(0)" ::: "memory"); else asm volatile("s_waitcnt vmcnt(6)" ::: "memory");
    __builtin_amdgcn_s_barrier();
    for (int kt = 0; kt < ntile; ++kt) {
        char* cur = lds + (kt & (NST - 1)) * AT_STAGE;
        if (kt + PD < ntile) stage(kt + PD, lds + ((kt + PD) & (NST - 1)) * AT_STAGE);
        __builtin_amdgcn_sched_barrier(0);
        const bool local = SWA && kt >= 4;
        const int kpos0 = local ? lo + (kt - 4) * 64 : 0;
        if (!SWA) {
            f32x16 S0, S1;
#pragma unroll
            for (int e = 0; e < 16; ++e) { S0[e] = -M2; S1[e] = -M2; }
#pragma unroll
            for (int ks = 0; ks < DQK / 16; ++ks) {
                const bf16x8 k0 = *(const bf16x8*)(cur + kb4[ks & 3] + (2048 * ks));
                const bf16x8 k1 = *(const bf16x8*)(cur + kb4[ks & 3] + (2048 * ks + 512));
                S0 = mfma32(k0, qf[ks], S0); S1 = mfma32(k1, qf[ks], S1);
            }
#pragma unroll
            for (int e = 0; e < 16; ++e) { S0[e] = __builtin_amdgcn_exp2f(S0[e]); lsum += S0[e]; }
#pragma unroll
            for (int s2 = 0; s2 < 2; ++s2) {
                const int a = s2 * 8;
                u32x4 pk;
                pk.x = cvt_pk_bf16n(S0[a + 0], S0[a + 1]); pk.y = cvt_pk_bf16n(S0[a + 2], S0[a + 3]);
                pk.z = cvt_pk_bf16n(S0[a + 4], S0[a + 5]); pk.w = cvt_pk_bf16n(S0[a + 6], S0[a + 7]);
                const bf16x8 pf = __builtin_bit_cast(bf16x8, pk);
#pragma unroll
                for (int md = 0; md < 4; ++md) {
                    const bf16x8 vf = *(const bf16x8*)(cur + AT_VOFF + vb2[md & 1] + (512 * md + 4096 * s2));
                    O[md] = mfma32(vf, pf, O[md]);
                }
#pragma unroll
                for (int e = a; e < a + 8; ++e) { S1[e] = __builtin_amdgcn_exp2f(S1[e]); lsum += S1[e]; }
            }
#pragma unroll
            for (int s2 = 0; s2 < 2; ++s2) {
                const int a = s2 * 8;
                u32x4 pk;
                pk.x = cvt_pk_bf16n(S1[a + 0], S1[a + 1]); pk.y = cvt_pk_bf16n(S1[a + 2], S1[a + 3]);
                pk.z = cvt_pk_bf16n(S1[a + 4], S1[a + 5]); pk.w = cvt_pk_bf16n(S1[a + 6], S1[a + 7]);
                const bf16x8 pf = __builtin_bit_cast(bf16x8, pk);
#pragma unroll
                for (int md = 0; md < 4; ++md) {
                    const bf16x8 vf = *(const bf16x8*)(cur + AT_VOFF + vb2[md & 1] + (512 * md + 4096 * (2 + s2)));
                    O[md] = mfma32(vf, pf, O[md]);
                }
            }
        } else
#pragma unroll
        for (int mk = 0; mk < 2; ++mk) {
            f32x16 S;
#pragma unroll
            for (int e = 0; e < 16; ++e) S[e] = -M2;
#pragma unroll
            for (int ks = 0; ks < DQK / 16; ++ks) {
                const bf16x8 kf = *(const bf16x8*)(cur + kb4[ks & 3] + (2048 * ks + 512 * mk));
                S = mfma32(kf, qf[ks], S);
            }
#pragma unroll
            for (int e = 0; e < 16; ++e) {
                float pv = __builtin_amdgcn_exp2f(S[e]);
                if (SWA) {
                    if (local) {
                        const int kp = kpos0 + mk * 32 + (e & 3) + 8 * (e >> 2) + 4 * h;
                        const int df = kp - qpos;
                        if (df > 128 || df < -128) pv = 0.f;
                    }
                }
                S[e] = pv; lsum += pv;
            }
#pragma unroll
            for (int s2 = 0; s2 < 2; ++s2) {
                const int a = s2 * 8;
                u32x4 pk;
                pk.x = cvt_pk_bf16n(S[a + 0], S[a + 1]); pk.y = cvt_pk_bf16n(S[a + 2], S[a + 3]);
                pk.z = cvt_pk_bf16n(S[a + 4], S[a + 5]); pk.w = cvt_pk_bf16n(S[a + 6], S[a + 7]);
                const bf16x8 pf = __builtin_bit_cast(bf16x8, pk);
#pragma unroll
                for (int md = 0; md < 4; ++md) {
                    const bf16x8 vf = *(const bf16x8*)(cur + AT_VOFF + vb2[md & 1] + (512 * md + 4096 * (mk * 2 + s2)));
                    O[md] = mfma32(vf, pf, O[md]);
                }
            }
            if (SWA) __builtin_amdgcn_sched_barrier(0);
        }
        if (!SWA && kt + PD < ntile) asm volatile("s_waitcnt vmcnt(6)" ::: "memory");
        else asm volatile("s_waitcnt vmcnt(0)" ::: "memory");
        asm volatile("s_waitcnt lgkmcnt(0)" ::: "memory");
        __builtin_amdgcn_s_barrier();
    }
    float l = lsum + __shfl_xor(lsum, 32, 64);
    if (SWA) l += sink_term_l2;
    const float inv = 1.f / l;
    const size_t tok = (size_t)b * SEQ + qpos;
#pragma unroll
    for (int md = 0; md < 4; ++md)
#pragma unroll
        for (int rq = 0; rq < 4; ++rq) {
            const int d0 = md * 32 + 8 * rq + 4 * h;
            const float o0 = O[md][rq * 4 + 0] * inv, o1 = O[md][rq * 4 + 1] * inv, o2 = O[md][rq * 4 + 2] * inv, o3 = O[md][rq * 4 + 3] * inv;
            if (SWA) { u32x2 o; o.x = cvt_pk_bf16(o0, o1); o.y = cvt_pk_bf16(o2, o3); *(u32x2*)(p.attn_out + tok * DM + 1024 + hs * 128 + d0) = o; }
            else if ((hs & 1) == 0) { park[(md * 4 + rq) * 2] = cvt_pk_bf16(o0, o1); park[(md * 4 + rq) * 2 + 1] = cvt_pk_bf16(o2, o3); }
            else { O[md][rq * 4 + 0] = o0; O[md][rq * 4 + 1] = o1; O[md][rq * 4 + 2] = o2; O[md][rq * 4 + 3] = o3; }
        }
    if (!SWA && (hs & 1)) {
        float ss = 0.f;
#pragma unroll
        for (int md = 0; md < 4; ++md)
#pragma unroll
            for (int rq = 0; rq < 4; ++rq) {
                const unsigned pa = park[(md * 4 + rq) * 2], pb = park[(md * 4 + rq) * 2 + 1];
                const float ax = __builtin_bit_cast(float, pa << 16), ay = __builtin_bit_cast(float, pa & 0xffff0000u), az = __builtin_bit_cast(float, pb << 16), aw = __builtin_bit_cast(float, pb & 0xffff0000u);
                const float e0 = ax - lam * O[md][rq * 4 + 0], e1 = ay - lam * O[md][rq * 4 + 1], e2 = az - lam * O[md][rq * 4 + 2], e3 = aw - lam * O[md][rq * 4 + 3];
                O[md][rq * 4 + 0] = e0; O[md][rq * 4 + 1] = e1; O[md][rq * 4 + 2] = e2; O[md][rq * 4 + 3] = e3;
                ss += e0 * e0 + e1 * e1 + e2 * e2 + e3 * e3;
            }
        ss += __shfl_xor(ss, 32, 64);
        const float rs = rsqrtf(ss * (1.f / 128.f) + EPSN) * 0.8f;
        float4 gq[4][4];
#pragma unroll
        for (int md = 0; md < 4; ++md)
#pragma unroll
            for (int rq = 0; rq < 4; ++rq) gq[md][rq] = *(const float4*)(p.diff_sub_g + md * 32 + 8 * rq + 4 * h);
#pragma unroll
        for (int md = 0; md < 4; ++md)
#pragma unroll
            for (int rq = 0; rq < 4; ++rq) {
                const int d0 = md * 32 + 8 * rq + 4 * h;
                const float4 g = gq[md][rq];
                u32x2 o; o.x = cvt_pk_bf16(O[md][rq * 4 + 0] * rs * g.x, O[md][rq * 4 + 1] * rs * g.y); o.y = cvt_pk_bf16(O[md][rq * 4 + 2] * rs * g.z, O[md][rq * 4 + 3] * rs * g.w);
                *(u32x2*)(p.attn_out + tok * DM + (hs >> 1) * 128 + d0) = o;
            }
    }
}
DEV void phase_attention(const Params& p, char* lds, int tid_) {
    const int lane = tid_ & 63, sub = __builtin_amdgcn_readfirstlane(tid_ >> 8), tl = tid_ & 255;
    char* ldsb = lds + sub * 65536;
    const float mq = wave_max(fabsf(p.diff_q_g[lane])), mk = wave_max(fabsf(p.diff_k_g[lane]));
    const float M2d = LOG2E * mq * 8.f * mk * 1.02f;
    const float msq = wave_max(fmaxf(fabsf(p.swa_q_g[lane]), fabsf(p.swa_q_g[lane + 64])));
    const float msk = wave_max(fmaxf(fabsf(p.swa_k_g[lane]), fabsf(p.swa_k_g[lane + 64])));
    const float M2s = LOG2E * msq * 11.313708498984761f * msk * 1.02f;
#ifndef ATT_ONLY
#define ATT_ONLY 3
#endif
    const float lam = expf(wave_sum(p.lq1[lane] * p.lk1[lane])) - expf(wave_sum(p.lq2[lane] * p.lk2[lane])) + 0.2f;
    if (ATT_ONLY & 1) for (int it0 = blockIdx.x; it0 < 512; it0 += gridDim.x) {
        const int it = (((it0 >> 8) * 8 + (it0 & 7)) * 2 + ((it0 >> 7) & 1)) * 16 + ((it0 >> 3) & 15);
        unsigned park[32];
#pragma unroll
        for (int i = 0; i < 32; ++i) park[i] = 0u;
        attn_item<64, false>(p, lds, tl, sub, (2 * it + sub) * 2 + 0, M2d, 0.f, lam, park);
        attn_item<64, false>(p, lds, tl, sub, (2 * it + sub) * 2 + 1, M2d, 0.f, lam, park);
    }
    if (ATT_ONLY & 2) for (int it0 = blockIdx.x; it0 < 512; it0 += gridDim.x) {
        const int it = (((it0 >> 8) * 8 + (it0 & 7)) * 2 + ((it0 >> 7) & 1)) * 16 + ((it0 >> 3) & 15);
        const int item = 2 * it + sub, j = (item >> 5) & 7;
        unsigned dummy[32]; attn_item<128, true>(p, ldsb, tl, sub, item, M2s, __builtin_amdgcn_exp2f(p.swa_sink[j] * LOG2E - M2s), 0.f, dummy);
    }
}

DEV void phase_norm2_route(const Params& p, char* lds, int layer, const float* xin, int tid_) {
    const int t = tid_, lane = t & 63, w = t >> 6;
    const unsigned nrj = layer == 0 ? CVT_ROUTE_JOBS : 0u;
    unsigned* te = (unsigned*)(lds);
    unsigned* lcnt = (unsigned*)(lds + 1024);
    unsigned* lrk = (unsigned*)(lds + 2048);
    const float* wg1 = p.wg1 + (size_t)layer * DM * 4;
    const float* wg2 = p.wg2 + (size_t)layer * DM * 32;
    for (int rb = blockIdx.x * 64; rb < NTOK; rb += gridDim.x * 64) {
        if (t < 32) lcnt[t] = 0u;
        __syncthreads();
        const int bidx = rb / SEQ;
        const float* md = p.mod + ((size_t)layer * 5 + bidx) * 12288;
#pragma unroll 1
        for (int j = 0; j < 4; ++j) {
            const int r0 = rb + 8 * w + 2 * j;
            float4 v0[8], v1[8];
            int lq = lane; asm volatile("" : "+v"(lq));
            row_load(xin + (size_t)r0 * DM, v0, lq); row_load(xin + (size_t)(r0 + 1) * DM, v1, lq);
            CvtJob ja, jb;
            const unsigned gtid = blockIdx.x * NTHR + tid_, gstride = gridDim.x * NTHR;
            const unsigned j0 = (unsigned)j * 4u;
            if (j0 + 1 < nrj) { ja.issue(p, layer, j0 * gstride + gtid); jb.issue(p, layer, (j0 + 1) * gstride + gtid); }
            const float rs0 = row_rstd(v0), rs1 = row_rstd(v1);
            row_modulate(v0, rs0, p.norm2_g + layer * DM, md + 8192, md + 6144, lq);
            __builtin_amdgcn_sched_barrier(0);
            row_modulate(v1, rs1, p.norm2_g + layer * DM, md + 8192, md + 6144, lq);
            __builtin_amdgcn_sched_barrier(0);
            row_store_bf16(p.h2 + (size_t)r0 * DM, v0, lq); row_store_bf16(p.h2 + (size_t)(r0 + 1) * DM, v1, lq);
            __builtin_amdgcn_sched_barrier(0);
            float* xs = (float*)(lds + 8192) + w * 4096;
#pragma unroll
            for (int i = 0; i < 8; ++i) { *(float4*)(xs + 4 * lq + 256 * i) = v0[i]; *(float4*)(xs + 2048 + 4 * lq + 256 * i) = v1[i]; }
            __builtin_amdgcn_sched_barrier(0);
            float* lg = (float*)(lds + 4096) + w * 72;
            {
                const int kk = lq >> 3, q = lq & 7;
                float e0[4] = {0.f, 0.f, 0.f, 0.f}, e1[4] = {0.f, 0.f, 0.f, 0.f};
                const float* wp = wg2 + (unsigned)(kk * 32 + 4 * q);
#pragma unroll 16
                for (int it = 0; it < 256; ++it) {
                    const float4 wv = *(const float4*)(wp + (unsigned)(it * 256));
                    const float xa = xs[8 * it + kk], xb = xs[2048 + 8 * it + kk];
                    e0[0] += xa * wv.x; e0[1] += xa * wv.y; e0[2] += xa * wv.z; e0[3] += xa * wv.w;
                    e1[0] += xb * wv.x; e1[1] += xb * wv.y; e1[2] += xb * wv.z; e1[3] += xb * wv.w;
                }
#pragma unroll
                for (int i = 0; i < 4; ++i) {
#pragma unroll
                    for (int m = 8; m <= 32; m <<= 1) { e0[i] += __shfl_xor(e0[i], m, 64); e1[i] += __shfl_xor(e1[i], m, 64); }
                }
                if (lane < 8) {
#pragma unroll
                    for (int i = 0; i < 4; ++i) { lg[4 + 4 * q + i] = e0[i]; lg[36 + 4 + 4 * q + i] = e1[i]; }
                }
                if (j0 + 1 < nrj) { ja.finish(); jb.finish(); }
                if (j0 + 3 < nrj) { ja.issue(p, layer, (j0 + 2) * gstride + gtid); jb.issue(p, layer, (j0 + 3) * gstride + gtid); }
                float g0[4] = {0.f, 0.f, 0.f, 0.f}, g1[4] = {0.f, 0.f, 0.f, 0.f};
#pragma unroll 16
                for (int it = 0; it < 32; ++it) {
                    const float4 wv = *(const float4*)(wg1 + (unsigned)((64 * it + lq) * 4));
                    const float xa = xs[64 * it + lq], xb = xs[2048 + 64 * it + lq];
                    g0[0] += xa * wv.x; g0[1] += xa * wv.y; g0[2] += xa * wv.z; g0[3] += xa * wv.w;
                    g1[0] += xb * wv.x; g1[1] += xb * wv.y; g1[2] += xb * wv.z; g1[3] += xb * wv.w;
                }
#pragma unroll
                for (int i = 0; i < 4; ++i) { g0[i] = wave_sum(g0[i]); g1[i] = wave_sum(g1[i]); }
                if (lane == 0) {
#pragma unroll
                    for (int i = 0; i < 4; ++i) { lg[i] = g0[i]; lg[36 + i] = g1[i]; }
                }
            }
            if (j0 + 3 < nrj) { ja.finish(); jb.finish(); }
            if (lane < 2) {
                const int rr = lane;
                const float* L = lg + 36 * rr;
                float gl[4];
#pragma unroll
                for (int i = 0; i < 4; ++i) gl[i] = L[i] + p.bg1[layer * 4 + i];
                int grp = 0; float gmx = gl[0];
#pragma unroll
                for (int i = 1; i < 4; ++i) if (gl[i] > gmx) { gmx = gl[i]; grp = i; }
                float den = 0.f;
#pragma unroll
                for (int i = 0; i < 4; ++i) den += expf(gl[i] - gmx);
                const float ptop = 1.f / den;
                float v1m = -3.4e38f, v2m = -3.4e38f; int i1 = 0, i2 = 0;
                for (int i = 0; i < 8; ++i) {
                    const float v = L[4 + grp * 8 + i] + p.bg2[layer * 32 + grp * 8 + i];
                    if (v > v1m) { v2m = v1m; i2 = i1; v1m = v; i1 = i; }
                    else if (v > v2m) { v2m = v; i2 = i; }
                }
                const float ex = expf(v2m - v1m);
                const int row = r0 + rr, la = (row - rb) * 2;
                te[la] = (unsigned)(grp * 8 + i1); te[la + 1] = (unsigned)(grp * 8 + i2);
                p.gatev[row * 2] = ptop / (1.f + ex); p.gatev[row * 2 + 1] = ptop * ex / (1.f + ex);
            }
        }
        __syncthreads();
        if (t < 128) lrk[t] = atomicAdd(&lcnt[te[t]], 1u);
        __syncthreads();
        if (t < 32) lcnt[32 + t] = atomicAdd(&p.cnt[layer * 32 + t], lcnt[t]);
        __syncthreads();
        if (t < 128) { const unsigned e = te[t], rk = lcnt[32 + e] + lrk[t]; p.route[rb * 2 + t] = (e << 16) | rk; p.inv[(size_t)e * 32768 + rk] = (unsigned)((rb * 2 + t) >> 1); }
        __syncthreads();
    }
    if (blockIdx.x * 64 >= NTOK) {
        CvtJob ja; const unsigned gtid = blockIdx.x * NTHR + tid_, gstride = gridDim.x * NTHR;
#pragma unroll 1
        for (unsigned j = 0; j < nrj; ++j) { ja.issue(p, layer, j * gstride + gtid); ja.finish(); }
    }
}

DEV const int* moe_tables(const Params& p, char* lds, int layer, int tid_) {
    int* tab = (int*)(lds + LDS_TAB);
    __syncthreads();
    if (tid_ == 0) {
        int up = 0, ro = 0;
        for (int e = 0; e < NEXP; ++e) {
            const int c = (int)p.cnt[layer * 32 + e];
            const int m = (c + 255) >> 8;
            tab[e] = up; tab[40 + e] = m; tab[80 + e] = ro; tab[120 + e] = c;
            up += m * 8; ro += m * 256;
        }
        tab[32] = up;
    }
    __syncthreads();
    return tab;
}
template <bool FINAL>
DEV void phase_combine(const Params& p, char* lds, int layer, const float* xin, float* xout, int tid_) {
    const int lane = tid_ & 63, w = tid_ >> 6;
    const int* tab = moe_tables(p, lds, layer, tid_);
    const u16* Y = (const u16*)p.regA + (size_t)NSLOT * DM;
    int rr = blockIdx.x * NW + w;
    float nga = 0.f, ngb = 0.f; unsigned nr0 = 0u, nr1 = 0u;
    if (rr < NTOK) { nga = p.gatev[rr * 2]; ngb = p.gatev[rr * 2 + 1]; nr0 = p.route[2 * rr]; nr1 = p.route[2 * rr + 1]; }
    for (; rr < NTOK; rr += gridDim.x * NW) {
        const int b = rr / SEQ;
        const float* md = p.mod + ((size_t)layer * 5 + b) * 12288;
        const float ga = nga, gb = ngb;
        const unsigned r0 = nr0, r1 = nr1;
        const u16* ya = Y + (size_t)((unsigned)tab[80 + (r0 >> 16)] + (r0 & 0xffffu)) * DM; const u16* yb = Y + (size_t)((unsigned)tab[80 + (r1 >> 16)] + (r1 & 0xffffu)) * DM;
        float4 v[8]; row_load(xin + (size_t)rr * DM, v, lane);
        u32x2 pa[8], pb[8]; float4 g2[8];
#pragma unroll
        for (int i = 0; i < 8; ++i) { const int c = 4 * lane + 256 * i; pa[i] = *(const u32x2*)(ya + c); pb[i] = *(const u32x2*)(yb + c); g2[i] = *(const float4*)(md + 10240 + c); }
        { const int rn = rr + gridDim.x * NW; if (rn < NTOK) { nga = p.gatev[rn * 2]; ngb = p.gatev[rn * 2 + 1]; nr0 = p.route[2 * rn]; nr1 = p.route[2 * rn + 1]; } }
        __builtin_amdgcn_sched_barrier(0);
#pragma unroll
        for (int i = 0; i < 8; ++i) {
            v[i].x += g2[i].x * (ga * __builtin_bit_cast(float, pa[i].x << 16) + gb * __builtin_bit_cast(float, pb[i].x << 16));
            v[i].y += g2[i].y * (ga * __builtin_bit_cast(float, pa[i].x & 0xffff0000u) + gb * __builtin_bit_cast(float, pb[i].x & 0xffff0000u));
            v[i].z += g2[i].z * (ga * __builtin_bit_cast(float, pa[i].y << 16) + gb * __builtin_bit_cast(float, pb[i].y << 16));
            v[i].w += g2[i].w * (ga * __builtin_bit_cast(float, pa[i].y & 0xffff0000u) + gb * __builtin_bit_cast(float, pb[i].y & 0xffff0000u));
        }
#pragma unroll
        for (int i = 0; i < 8; ++i) *(float4*)(xout + (size_t)rr * DM + 4 * lane + 256 * i) = v[i];
        if (!FINAL) {
            const float* md1 = p.mod + ((size_t)(layer + 1) * 5 + b) * 12288;
            const float rstd = row_rstd(v);
            row_modulate(v, rstd, p.norm1_g + (layer + 1) * DM, md1 + 2048, md1, lane);
            row_store_bf16(p.h + (size_t)rr * DM, v, lane);
        }
    }
}

template <class T> DEV T* uni(T* p) {
    const unsigned long long v = (unsigned long long)p;
    const unsigned lo = __builtin_amdgcn_readfirstlane((unsigned)v), hi = __builtin_amdgcn_readfirstlane((unsigned)(v >> 32));
    typedef T __attribute__((address_space(1))) * GP;
    return (T*)(GP)(((unsigned long long)hi << 32) | lo);
}
template <class T> DEV T ldg(const T* base, unsigned idx) { return *(const T*)((const char*)base + idx * (unsigned)sizeof(T)); }
template <class T> DEV void stg(T* base, unsigned idx, T v) { *(T*)((char*)base + idx * (unsigned)sizeof(T)) = v; }
DEV int tid_opaque(int tl) { int t = tl; asm volatile("" : "+v"(t)); return t; }
DEV float sbrk(float v) { asm("" : "+v"(v)); return v; }
DEV float2 cmul(float2 a, float2 b) { return make_float2(sbrk(a.x * b.x - a.y * b.y), sbrk(a.x * b.y + a.y * b.x)); }
DEV float2 cmulc(float2 a, float2 b) { return make_float2(sbrk(a.x * b.x + a.y * b.y), sbrk(a.y * b.x - a.x * b.y)); }
DEV int PIX(int i) { return i + (i >> 4); }
constexpr int FA = 4352;
constexpr float cCos16[8] = {1.f, 0.92387953251128674f, 0.70710678118654752f, 0.38268343236508977f, 0.f, -0.38268343236508977f, -0.70710678118654752f, -0.92387953251128674f};
constexpr float cSin16[8] = {0.f, 0.38268343236508977f, 0.70710678118654752f, 0.92387953251128674f, 1.f, 0.92387953251128674f, 0.70710678118654752f, 0.38268343236508977f};
constexpr int brev4(int v) { return ((v & 1) << 3) | ((v & 2) << 1) | ((v & 4) >> 1) | ((v & 8) >> 3); }
template <bool INV> DEV void dft16(float2 (&a)[16]) {
#pragma unroll
    for (int half = 8; half >= 1; half >>= 1) {
#pragma unroll
        for (int blk = 0; blk < 16; blk += 2 * half) {
#pragma unroll
            for (int i = 0; i < half; ++i) {
                const float2 u = a[blk + i], v = a[blk + i + half];
                a[blk + i] = make_float2(sbrk(u.x + v.x), sbrk(u.y + v.y));
                const float2 d = make_float2(sbrk(u.x - v.x), sbrk(u.y - v.y));
                const int ti = i * (8 / half);
                if (ti == 0) a[blk + i + half] = d;
                else if (ti == 4) a[blk + i + half] = INV ? make_float2(-d.y, d.x) : make_float2(d.y, -d.x);
                else {
                    const float c = cCos16[ti], s = INV ? cSin16[ti] : -cSin16[ti];
                    a[blk + i + half] = make_float2(sbrk(d.x * c - d.y * s), sbrk(d.x * s + d.y * c));
                }
            }
        }
    }
    float2 b[16];
#pragma unroll
    for (int k = 0; k < 16; ++k) b[k] = a[brev4(k)];
#pragma unroll
    for (int k = 0; k < 16; ++k) a[k] = b[k];
}
template <bool CONJ> DEV void apply_pows16(float2 (&a)[16], float2 w1) {
    float2 B[4]; B[0] = make_float2(1.f, 0.f); B[1] = w1; B[2] = cmul(w1, w1); B[3] = cmul(B[2], w1);
    const float2 w4 = cmul(B[2], B[2]);
    float2 A = make_float2(1.f, 0.f);
#pragma unroll
    for (int q = 0; q < 4; ++q) {
#pragma unroll
        for (int b = 0; b < 4; ++b) {
            if (q == 0 && b == 0) continue;
            const float2 wk = (q == 0) ? B[b] : (b == 0 ? A : cmul(A, B[b]));
            a[q * 4 + b] = CONJ ? cmulc(a[q * 4 + b], wk) : cmul(a[q * 4 + b], wk);
        }
        A = cmul(A, w4);
    }
}
DEV void twA_load(float2 (&w)[16], const float2* twA, int tl) {
    const int t = tid_opaque(tl);
#pragma unroll
    for (int k = 1; k < 16; ++k) w[k] = ldg(twA, (unsigned)(k * 256 + t));
}
DEV void fA_fwd(float2* X, const float2 (&w)[16], float2 (&a)[16], int tl) {
    const int t = tid_opaque(tl);
    dft16<false>(a);
#pragma unroll
    for (int k = 1; k < 16; ++k) a[k] = cmul(a[k], w[k]);
    float2* Xb = X + (t + (t >> 4));
#pragma unroll
    for (int k = 0; k < 16; ++k) Xb[272 * k] = a[k];
}
DEV void fA_inv_read(const float2* X, float2 (&a)[16], int tl) {
    const int t = tid_opaque(tl);
    const float2* Xb = X + (t + (t >> 4));
#pragma unroll
    for (int k = 0; k < 16; ++k) a[k] = Xb[272 * k];
}
DEV void fA_inv_math(const float2 (&w)[16], float2 (&a)[16]) {
#pragma unroll
    for (int k = 1; k < 16; ++k) a[k] = cmulc(a[k], w[k]);
    dft16<true>(a);
}
template <bool INV> DEV void fB2(float2* X, const float2* tw  , int tl) {
    const int id = tid_opaque(tl), k = id >> 4, j2 = id & 15;
    float2 a[16], b[16], w[16];
    float2* Xa = X + PIX(256 * k + j2);
    float2* Xb = Xa + FA;
#pragma unroll
    for (int m = 1; m < 16; ++m) w[m] = tw[m * 16 + j2];
#pragma unroll
    for (int m = 0; m < 16; ++m) { a[m] = Xa[17 * m]; b[m] = Xb[17 * m]; }
    __builtin_amdgcn_sched_barrier(0);
    if (!INV) {
        dft16<false>(a); dft16<false>(b);
#pragma unroll
        for (int m = 1; m < 16; ++m) { a[m] = cmul(a[m], w[m]); b[m] = cmul(b[m], w[m]); }
    } else {
#pragma unroll
        for (int m = 1; m < 16; ++m) { a[m] = cmulc(a[m], w[m]); b[m] = cmulc(b[m], w[m]); }
        dft16<true>(a); dft16<true>(b);
    }
#pragma unroll
    for (int m = 0; m < 16; ++m) { Xa[17 * m] = a[m]; Xb[17 * m] = b[m]; }
}
DEV void fC2_store(const float2* X, float2* ksp, float scale, int tl) {
    const int t = tid_opaque(tl);
    const float2* Xa = X + 17 * t;
    float2 a[16], b[16];
#pragma unroll
    for (int m = 0; m < 16; ++m) { a[m] = Xa[m]; b[m] = Xa[FA + m]; }
    dft16<false>(a); dft16<false>(b);
#pragma unroll
    for (int m = 0; m < 16; ++m) { stg(ksp, (unsigned)(m * 256 + t), make_float2(a[m].x * scale, a[m].y * scale)); stg(ksp, (unsigned)(4096 + m * 256 + t), make_float2(b[m].x * scale, b[m].y * scale)); }
}
DEV void fC2_mul(float2* X, const float2* ksp, int tl) {
    const int t = tid_opaque(tl);
    float2* Xa = X + 17 * t;
    float2 a[16], b[16];
#pragma unroll
    for (int m = 0; m < 16; ++m) { a[m] = Xa[m]; b[m] = Xa[FA + m]; }
    dft16<false>(a); dft16<false>(b);
#pragma unroll
    for (int m = 0; m < 16; ++m) { a[m] = cmul(a[m], ldg(ksp, (unsigned)(m * 256 + t))); b[m] = cmul(b[m], ldg(ksp, (unsigned)(4096 + m * 256 + t))); }
    dft16<true>(a); dft16<true>(b);
#pragma unroll
    for (int m = 0; m < 16; ++m) { Xa[m] = a[m]; Xa[FA + m] = b[m]; }
}
template <bool MUL> DEV void sconv_fill(float2 (&a)[16], const u16* row  , int zrow, int b0, const float* cw, const float* cb_, int tl) {
    const int t = tid_opaque(tl);
    float w0 = cw[zrow], w1 = cw[6144 + zrow], w2 = cw[12288 + zrow], cb = cb_[zrow];
    const unsigned i0 = (unsigned)(zrow * NTOK + b0 * SEQ + t);
#pragma unroll
    for (int m = 0; m < 16; ++m) {
        const unsigned i = i0 + 256u * m;
        float l0, l1, r0, r1;
        if (m == 0)  { const unsigned o = t > 0 ? 1u : 0u; const float k = t > 0 ? 1.f : 0.f; l0 = k * bf2f(ldg(row, i - o)); l1 = k * bf2f(ldg(row, i + SEQ - o)); }
        else         { l0 = bf2f(ldg(row, i - 1)); l1 = bf2f(ldg(row, i + SEQ - 1)); }
        if (m == 15) { const unsigned o = t < 255 ? 1u : 0u; const float k = t < 255 ? 1.f : 0.f; r0 = k * bf2f(ldg(row, i + o)); r1 = k * bf2f(ldg(row, i + SEQ + o)); }
        else         { r0 = bf2f(ldg(row, i + 1)); r1 = bf2f(ldg(row, i + SEQ + 1)); }
        const float v0 = cb + w0 * l0 + w1 * bf2f(ldg(row, i)) + w2 * r0;
        const float v1 = cb + w0 * l1 + w1 * bf2f(ldg(row, i + SEQ)) + w2 * r1;
        if (MUL) { a[m].x *= v0; a[m].y *= v1; } else a[m] = make_float2(v0, v1);
        if ((m & 3) == 3) __builtin_amdgcn_sched_barrier(0);
    }
}
struct SconvRows { unsigned l[16], c[16], r[16]; };
DEV void sconv_load(SconvRows& q, const u16* row, int zrow, int b0, int tl) {
    const int t = tid_opaque(tl);
    const unsigned i0 = (unsigned)(zrow * NTOK + b0 * SEQ + t);
#pragma unroll
    for (int m = 0; m < 16; ++m) {
        const unsigned i = i0 + 256u * m;
        const unsigned ol = (m == 0) ? (t > 0 ? 1u : 0u) : 1u, orr = (m == 15) ? (t < 255 ? 1u : 0u) : 1u;
        q.l[m] = (unsigned)ldg(row, i - ol)  | ((unsigned)ldg(row, i + SEQ - ol) << 16);
        q.c[m] = (unsigned)ldg(row, i)       | ((unsigned)ldg(row, i + SEQ) << 16);
        q.r[m] = (unsigned)ldg(row, i + orr) | ((unsigned)ldg(row, i + SEQ + orr) << 16);
    }
}
DEV void sconv_apply_mul(float2 (&a)[16], const SconvRows& q, int zrow, const float* cw, const float* cb_, int tl) {
    const int t = tid_opaque(tl);
    const float w0 = cw[zrow], w1 = cw[6144 + zrow], w2 = cw[12288 + zrow], cb = cb_[zrow];
#pragma unroll
    for (int m = 0; m < 16; ++m) {
        const float kl = (m == 0) ? (t > 0 ? 1.f : 0.f) : 1.f, kr = (m == 15) ? (t < 255 ? 1.f : 0.f) : 1.f;
        const float v0 = cb + w0 * (kl * __builtin_bit_cast(float, q.l[m] << 16)) + w1 * __builtin_bit_cast(float, q.c[m] << 16) + w2 * (kr * __builtin_bit_cast(float, q.r[m] << 16));
        const float v1 = cb + w0 * (kl * __builtin_bit_cast(float, q.l[m] & 0xffff0000u)) + w1 * __builtin_bit_cast(float, q.c[m] & 0xffff0000u) + w2 * (kr * __builtin_bit_cast(float, q.r[m] & 0xffff0000u));
        a[m].x *= v0; a[m].y *= v1;
    }
}
template <class F> DEV void conv_fwdA(float2* X, const float2* tw, const float2* twA, const float2 (&z)[16], int tl, F&& side_issue) {
    float2 a[16], b[16], w[16];
    const int t = tid_opaque(tl);
    twA_load(w, twA, tl);
#pragma unroll
    for (int m = 0; m < 16; ++m) b[m] = ldg(tw, (unsigned)(t + 256 * m));
    __builtin_amdgcn_sched_barrier(0);
    side_issue();
    __builtin_amdgcn_sched_barrier(0);
#pragma unroll
    for (int m = 0; m < 16; ++m) a[m] = z[m];
    fA_fwd(X, w, a, tl);
#pragma unroll
    for (int m = 0; m < 16; ++m) a[m] = cmul(z[m], b[m]);
    fA_fwd(X + FA, w, a, tl);
}
template <class F> DEV void conv_invA(const float2* X, const float2* tw, const float2* twA, float2 (&z)[16], int tl, F&& side_issue) {
    float2 o[16];
    const int t = tid_opaque(tl);
    float2 w1 = ldg(twA, (unsigned)(256 + t));
    const float2 wb = ldg(tw, (unsigned)t);
    fA_inv_read(X, z, tl); fA_inv_read(X + FA, o, tl);
    __builtin_amdgcn_sched_barrier(0);
    side_issue();
    asm volatile("" : "+v"(w1.x), "+v"(w1.y));
    {
        float2 wk = w1;
#pragma unroll
        for (int k = 1; k < 16; ++k) { z[k] = cmulc(z[k], wk); o[k] = cmulc(o[k], wk); if (k < 15) wk = cmul(wk, w1); }
    }
    dft16<true>(z); dft16<true>(o);
#pragma unroll
    for (int m = 0; m < 16; ++m) {
        constexpr float c32[16] = {1.0f, 0.9807852804032304f, 0.9238795325112867f, 0.8314696123025452f, 0.7071067811865476f, 0.5555702330196023f, 0.38268343236508984f, 0.19509032201612833f, 0.00000000000000006123f, -0.1950903220161282f, -0.3826834323650897f, -0.555570233019602f, -0.7071067811865475f, -0.8314696123025453f, -0.9238795325112867f, -0.9807852804032304f}, s32[16] = {0.0f, 0.19509032201612825f, 0.3826834323650898f, 0.5555702330196022f, 0.7071067811865475f, 0.8314696123025452f, 0.9238795325112867f, 0.9807852804032304f, 1.0f, 0.9807852804032304f, 0.9238795325112867f, 0.8314696123025455f, 0.7071067811865476f, 0.5555702330196022f, 0.3826834323650899f, 0.1950903220161286f};
        const float2 wm = cmul(wb, make_float2(c32[m], -s32[m])); const float2 r = cmulc(o[m], wm); z[m].x += r.x; z[m].y += r.y; }
}
DEV int conv_lane_fresh() { unsigned z = 0u; asm volatile("" : "+v"(z)); return (int)__builtin_amdgcn_mbcnt_hi(~0u, __builtin_amdgcn_mbcnt_lo(~0u, z)); }
DEV void phase_hy_conv(const Params& p, char* lds, int tid_) {
    const int wv_ = __builtin_amdgcn_readfirstlane(tid_ >> 6), sub = wv_ >> 2;
#define CONV_LANE() conv_lane_fresh()
#define tl ((wv_ & 3) * 64 + CONV_LANE())
    float2* X = (float2*)(lds + sub * 69632);
    const u16* zT = uni(p.regB);
    float2* ksp = uni(p.ksp + (size_t)(blockIdx.x * 2 + sub) * 2 * 8192);
    const float2* tw = uni(p.tw); const float2* twA = tw + 8192;
    float2* twB = (float2*)(lds + LDS_TAB);
    if (tid_ < 256) twB[tid_] = tw[12288 + tid_];
    __syncthreads();
    const unsigned gstride = gridDim.x * NTHR, njobs = (NEXP * 3u * 65536u + gstride - 1u) / gstride;
#define gtid ((unsigned)(blockIdx.x * NTHR + wv_ * 64 + CONV_LANE()))
    unsigned jn = 0u;
    CvtJob cj;
#define CJ_ISSUE() do { if (jn < njobs) cj.issue(p, 1, jn * gstride + gtid); } while (0)
#define CJ_FINISH() do { if (jn < njobs) { cj.finish(); ++jn; } } while (0)
#pragma unroll 1
    for (int c = blockIdx.x * 2 + sub; c < DM; c += gridDim.x * 2) {
        const float dl = fabsf(-3.0701134573253946f + (-15.350567286626973f + 3.0701134573253946f) * (float)c / 2047.f) * (1.f / (float)(SEQ - 1));
#pragma unroll 1
        for (int o = 0; o < 2; ++o) {
            const unsigned hfo = (unsigned)((o * 4096 + c) * SEQ), hbo = (unsigned)((o * 4096 + 2048 + c) * SEQ);
            const float bias = p.hy_bias[o * DM + c];
            CJ_ISSUE();
            __syncthreads();
            {
                const int t = tid_opaque(tl);
                u16 lv[16], hv[16];
#pragma unroll
                for (int m = 0; m < 16; ++m) {
                    const int n = t + 256 * m;
                    const int nb = n == 0 ? 1 : SEQ - n;
                    lv[m] = ((const u16*)p.filtT)[hfo + (unsigned)n]; hv[m] = ((const u16*)p.filtT)[hbo + (unsigned)nb];
                }
                float sm[16], df[16];
#pragma unroll
                for (int m = 0; m < 16; ++m) {
                    const int n = t + 256 * m;
                    const int nb = n == 0 ? 1 : SEQ - n;
                    const float lo = bf2f(lv[m]) * __expf(-(float)n * dl) + (n == 0 ? bias : 0.f);
                    const float hi = (n == 0 ? 0.f : 1.f) * (bf2f(hv[m]) * __expf(-(float)nb * dl));
                    sm[m] = lo + hi; df[m] = lo - hi;
                }
                float2 a[16], wa[16];
                twA_load(wa, twA, tl);
#pragma unroll
                for (int m = 0; m < 16; ++m) a[m] = make_float2(sm[m], 0.f);
                fA_fwd(X, wa, a, tl);
#pragma unroll
                for (int m = 0; m < 16; ++m) { const float2 w = ldg(tw, (unsigned)(t + 256 * m)); a[m] = make_float2(df[m] * w.x, df[m] * w.y); }
                fA_fwd(X + FA, wa, a, tl);
            }
            __syncthreads();
            CJ_FINISH(); CJ_ISSUE();
            fB2<false>(X, twB, tl);
            asm volatile("s_waitcnt lgkmcnt(0)" ::: "memory"); __builtin_amdgcn_wave_barrier(); __builtin_amdgcn_sched_barrier(0);
            fC2_store(X, ksp + o * 8192, 1.f / 8192.f, tl);
            CJ_FINISH();
        }
#pragma unroll 1
        for (int pr = 0; pr < 2; ++pr) {
            const int b0 = 2 * pr;
            float2 z[16];
            sconv_fill<false>(z, zT, c, b0, p.hy_conv_w, p.hy_conv_b, tl);
            __syncthreads();
#pragma unroll 1
            for (int o = 0; o < 2; ++o) {
                conv_fwdA(X, tw, twA, z, tl, [&]() { CJ_ISSUE(); });
                __syncthreads();
                CJ_FINISH(); CJ_ISSUE();
                fB2<false>(X, twB, tl);
                asm volatile("s_waitcnt lgkmcnt(0)" ::: "memory"); __builtin_amdgcn_wave_barrier(); __builtin_amdgcn_sched_barrier(0);
                fC2_mul(X, ksp + o * 8192, tl);
                asm volatile("s_waitcnt lgkmcnt(0)" ::: "memory"); __builtin_amdgcn_wave_barrier(); __builtin_amdgcn_sched_barrier(0);
                fB2<true>(X, twB, tl);
                __syncthreads();
                CJ_FINISH();
                SconvRows sq;
                conv_invA(X, tw, twA, z, tl, [&]() { sconv_load(sq, zT, (o + 1) * 2048 + c, b0, tl); });
                __builtin_amdgcn_sched_barrier(0);
                sconv_apply_mul(z, sq, (o + 1) * 2048 + c, p.hy_conv_w, p.hy_conv_b, tl);
            }
            const int t = tid_opaque(tl);
            u16* y2T = (u16*)p.regC;
#pragma unroll
            for (int m = 0; m < 16; ++m) { y2T[(unsigned)(c * NTOK + b0 * SEQ + t + 256 * m)] = f2bf(z[m].x); y2T[(unsigned)(c * NTOK + b0 * SEQ + SEQ + t + 256 * m)] = f2bf(z[m].y); }
        }
        __syncthreads();
    }
    {
        const Params* pp = &p; asm volatile("" : "+s"(pp));
        const Params& p = *pp;
#pragma unroll 1
        while (jn < njobs) { CJ_ISSUE(); CJ_FINISH(); }
    }
#undef CJ_ISSUE
#undef CJ_FINISH
#undef gtid
#undef tl
#undef CONV_LANE
}
DEV void phase_transpose_y2(const Params& p, char* lds, int tid_) {
    const u16* src = (const u16*)p.regC; u16* dst = (u16*)p.regC + (size_t)DM * NTOK;
    u16* tl = (u16*)lds;
    const int t = tid_;
    auto tload = [&](int j) -> u32x4 { const int ct = j & 31, tt = j >> 5, r = t >> 3, ch = (t & 7) * 8; return *(const u32x4*)(src + (size_t)(ct * 64 + r) * NTOK + tt * 64 + ch); };
    u32x4 nxt = tload(blockIdx.x);
    for (int j = blockIdx.x; j < 32 * 256; j += gridDim.x) {
        const int ct = j & 31, tt = j >> 5;
        { const int r = t >> 3, ch = (t & 7) * 8;
          *(u32x4*)(tl + r * 72 + ch) = nxt; }
        if (j + (int)gridDim.x < 32 * 256) nxt = tload(j + gridDim.x);
        __syncthreads();
        { const int r = t >> 3, ch = (t & 7) * 8;
          u16 v[8];
#pragma unroll
          for (int k = 0; k < 8; ++k) v[k] = tl[(ch + k) * 72 + r];
          u32x4 o; o.x = v[0] | ((unsigned)v[1] << 16); o.y = v[2] | ((unsigned)v[3] << 16); o.z = v[4] | ((unsigned)v[5] << 16); o.w = v[6] | ((unsigned)v[7] << 16);
          *(u32x4*)(dst + (size_t)(tt * 64 + r) * DM + ct * 64 + ch) = o; }
        __syncthreads();
    }
}

__global__ void __launch_bounds__(NTHR, 2) mega(Params p_) {
    extern __shared__ __attribute__((aligned(16))) char lds[];
    LAS unsigned char* ldsl = (LAS unsigned char*)lds;
    uint4* xbw = (uint4*)(lds + LDS_BYTES - 16);
    const int widx_ = __builtin_amdgcn_readfirstlane(threadIdx.x >> 6);
    const int ph_lo = p_.ph_lo, ph_hi = p_.ph_hi;
    const bool multi = (ph_hi - ph_lo) > 1;
    XcdBarrier bar;
    bar.bar = p_.bar; bar.x = 0; bar.st = (volatile LAS unsigned*)xbw;
    if (multi) {
        if (threadIdx.x == 0) *xbw = make_uint4(0u, 0u, 0u, 0u);
        __syncthreads();
        bar = xcd_barrier_post(p_.bar, (volatile LAS unsigned*)xbw);
    }
#ifndef ONLY_PHASE
#define ONLY_PHASE -1
#endif
#define PH(n, ...) if ((ONLY_PHASE < 0 || ONLY_PHASE == (n)) && ph_lo <= (n) && (n) < ph_hi) { \
        const __attribute__((address_space(4))) char* kp_ = (const __attribute__((address_space(4))) char*)__builtin_amdgcn_kernarg_segment_ptr(); asm volatile("" : "+s"(kp_)); \
        const Params& p = *(const Params*)kp_; const int tid_ = widx_ * 64 + (int)__builtin_amdgcn_mbcnt_hi(~0u, __builtin_amdgcn_mbcnt_lo(~0u, 0u)); __VA_ARGS__; if ((n) + 1 < ph_hi) xcd_barrier(bar, widx_ * 64 + conv_lane_fresh()); }
    PH(0,  phase_prologue(p, lds, tid_))
    PH(1,  { phase_norm1_l0(p, tid_); pg8::StaticOrder S; S.init(p.wt_w3, p.a2p, 8192, SEQ, 256); EpiBf16Store E{(u16*)p.filtT, SEQ, nullptr}; pg8::gemm_phase<false>(ldsl, 256, S, E, tid_); })
    PH(2,  { pg8::StaticOrder S; S.init(p.h, p.wt_attn_in, NROW, AIN, DM); EpiQKNorm E{p.regB, p.gains, (float*)(lds + 131072), (char*)p.regA}; pg8::gemm_phase<false>(ldsl, DM, S, E, tid_); })
    PH(4,  phase_attention(p, lds, tid_))
    PH(6,  { pg8::StaticOrder S; S.init(p.attn_out, p.wt_attn_out, NTOK, DM, DM); EpiResid E{p.x, p.x1, p.mod + 4096, nullptr}; pg8::gemm_phase<false>(ldsl, DM, S, E, tid_); })
    PH(7,  phase_norm2_route(p, lds, 0, p.x1, tid_))
    PH(9,  { const int* tab = moe_tables(p, lds, 0, tid_); pg8::MoeOrder S; S.init(p.h2, DM, p.wt_gu, (size_t)2048 * 2048, tab, p.inv); EpiMoe1 E{p.act}; pg8::gemm_phase<true>(ldsl, DM, S, E, tid_); })
    PH(10, { const int* tab = moe_tables(p, lds, 0, tid_); pg8::MoeOrder S; S.init(p.act, FF, p.wt_dn, (size_t)2048 * 1024, tab, nullptr); EpiBf16Store E{(u16*)p.regA + (size_t)NSLOT * DM, DM, nullptr}; pg8::gemm_phase<false>(ldsl, FF, S, E, tid_); })
    PH(11, phase_combine<false>(p, lds, 0, p.x1, p.x2, tid_))
    PH(12, { pg8::StaticOrder S; S.init(p.wt_hy_in, p.h, 6144, NTOK, DM); EpiBf16Store E{p.regB, NTOK, p.hy_b_in}; pg8::gemm_phase<false>(ldsl, DM, S, E, tid_); })
    PH(13, phase_hy_conv(p, lds, tid_))
    PH(14, phase_transpose_y2(p, lds, tid_))
    PH(15, { pg8::StaticOrder S; S.init((u16*)p.regC + (size_t)DM * NTOK, p.wt_hy_out, NTOK, DM, DM); EpiResid E{p.x2, p.x1, p.mod + (size_t)5 * 12288 + 4096, p.hy_b_out}; pg8::gemm_phase<false>(ldsl, DM, S, E, tid_); })
    PH(16, phase_norm2_route(p, lds, 1, p.x1, tid_))
    PH(18, { const int* tab = moe_tables(p, lds, 1, tid_); pg8::MoeOrder S; S.init(p.h2, DM, p.wt_gu, (size_t)2048 * 2048, tab, p.inv); EpiMoe1 E{p.act}; pg8::gemm_phase<true>(ldsl, DM, S, E, tid_); })
    PH(19, { const int* tab = moe_tables(p, lds, 1, tid_); pg8::MoeOrder S; S.init(p.act, FF, p.wt_dn, (size_t)2048 * 1024, tab, nullptr); EpiBf16Store E{(u16*)p.regA + (size_t)NSLOT * DM, DM, nullptr}; pg8::gemm_phase<false>(ldsl, FF, S, E, tid_); })
    PH(20, (phase_combine<true>(p, lds, 1, p.x1, p.out, tid_)))
}

extern "C" void kernel_launch(void* const* d_in, const int* in_sizes, int n_in, void* d_out, int out_size, void* d_ws, size_t ws_size, hipStream_t stream) {
    static int grid = 0;
    if (!grid) {
        int dev = 0, cus = 0, per_cu = 0;
        (void)hipGetDevice(&dev);
        (void)hipDeviceGetAttribute(&cus, hipDeviceAttributeMultiprocessorCount, dev);
        (void)hipFuncSetAttribute((const void*)mega, hipFuncAttributeMaxDynamicSharedMemorySize, LDS_BYTES);
        (void)hipOccupancyMaxActiveBlocksPerMultiprocessor(&per_cu, mega, NTHR, LDS_BYTES);
        if (per_cu > 1) per_cu = 1;
        if (per_cu < 1) per_cu = 1;
        grid = cus * per_cu;
    }
    Params p; memset(&p, 0, sizeof(p));
    const float* const* in = (const float* const*)d_in;
    p.x = in[0]; p.c = in[1]; p.ctx = in[2]; p.c_ctx = in[3]; p.ada_w = in[4]; p.ada_b = in[5]; p.norm1_g = in[6]; p.norm2_g = in[7];
    p.attn_w_in = in[8]; p.attn_w_out = in[9]; p.diff_q_g = in[10]; p.diff_k_g = in[11]; p.lq1 = in[12]; p.lk1 = in[13]; p.lq2 = in[14]; p.lk2 = in[15];
    p.diff_sub_g = in[16]; p.swa_q_g = in[17]; p.swa_k_g = in[18]; p.swa_sink = in[19];
    p.hy_w_in = in[20]; p.hy_b_in = in[21]; p.hy_conv_w = in[22]; p.hy_conv_b = in[23];
    p.flt_w1 = in[24]; p.flt_b1 = in[25]; p.flt_f1 = in[26]; p.flt_w2 = in[27]; p.flt_b2 = in[28]; p.flt_f2 = in[29]; p.flt_w3 = in[30];
    p.hy_bias = in[31]; p.hy_w_out = in[32]; p.hy_b_out = in[33];
    p.wg1 = in[34]; p.bg1 = in[35]; p.wg2 = in[36]; p.bg2 = in[37]; p.w_gate = in[38]; p.w_up = in[39]; p.w_down = in[40];
    p.out = (float*)d_out;
    char* ws = (char*)d_ws; size_t off = 0;
    auto take = [&](size_t bytes) { char* r = ws + off; off += (bytes + 255) & ~(size_t)255; return r; };
    p.bar = (unsigned*)take(XCD_BAR_WORDS * 4);
    p.mod = (float*)take((size_t)2 * 5 * 12288 * 4);
    p.tw = (float2*)take((8192 + 4096 + 256) * 8);
    p.a2p = (u16*)take((size_t)4096 * 256 * 2);
    p.gains = (float*)take(512 * 4);
    p.cnt = (unsigned*)take(64 * 4);
    p.route = (unsigned*)take((size_t)32768 * 4);
    p.inv = (unsigned*)take((size_t)NEXP * 32768 * 4);
    p.gatev = (float*)take((size_t)32768 * 4);
    p.wt_attn_in = (u16*)take((size_t)AIN * DM * 2);
    p.wt_attn_out = (u16*)take((size_t)DM * DM * 2);
    p.wt_hy_in = (u16*)take((size_t)6144 * DM * 2);
    p.wt_hy_out = (u16*)take((size_t)DM * DM * 2);
    p.wt_w3 = (u16*)take((size_t)8192 * 256 * 2);
    p.wt_gu = (u16*)take((size_t)NEXP * 2048 * 2048 * 2);
    p.wt_dn = (u16*)take((size_t)NEXP * 2048 * 1024 * 2);
    p.h = (u16*)take((size_t)NROW * DM * 2);
    p.regA = (float*)take((size_t)NSLOT * DM * 2 * 2);
    p.regB = (u16*)take((size_t)6144 * NTOK * 2);
    p.regC = (float*)take((size_t)NTOK * DM * 4);
    p.attn_out = (u16*)take((size_t)NTOK * DM * 2);
    p.x1 = (float*)take((size_t)NTOK * DM * 4);
    p.x2 = (float*)take((size_t)NTOK * DM * 4);
    p.h2 = (u16*)take((size_t)NTOK * DM * 2);
    p.act = (u16*)take((size_t)NSLOT * FF * 2);
    p.filtT = (float*)take((size_t)8192 * SEQ * 4);
    p.ksp = (float2*)take((size_t)grid * 2 * 2 * 8192 * 8);
#ifndef HOST_DUP_MASK
#define HOST_DUP_MASK 0
#endif
#if N_LAUNCH_SPLIT
    for (int ph = 0; ph < NPHASE; ++ph) {
        p.ph_lo = ph; p.ph_hi = ph + 1;
        for (int rep = 0; rep <= ((HOST_DUP_MASK >> ph) & 1); ++rep)
            hipLaunchKernelGGL(mega, dim3(grid), dim3(NTHR), LDS_BYTES, stream, p);
    }
#else
    (void)hipMemsetAsync(p.bar, 0, XCD_BAR_WORDS * 4, stream);
    p.ph_lo = 0; p.ph_hi = NPHASE;
    hipLaunchKernelGGL(mega, dim3(grid), dim3(NTHR), LDS_BYTES, stream, p);
#endif
}
```
